# Optimizing an MI355X kernel written in HIP

```python
import math
import jax
import jax.numpy as jnp
from jax import lax
import numpy as np

D_MODEL = 1024
BATCH = 2
SEQ = 16384
DEPTH = 1

CHUNK = 64
N_META = 16
D_MIX = D_MODEL
ATT_W = D_MIX // 2
ATT_HEADS = 4
HEAD_DIM = ATT_W // (2 * ATT_HEADS)
ATT_Q = ATT_HEADS * 2 * HEAD_DIM
ATT_V = ATT_HEADS * 2 * HEAD_DIM
SSM_W = D_MIX - ATT_W
SSM_CG = 16
SSM_G = SSM_W // SSM_CG
SSM_N = 64
IN_COLS = 2 * ATT_Q + ATT_V + SSM_W
N_BUCKETS = 32
MAX_DISTANCE = 128
Q_BLOCK = 128
N_EXPERTS = 32
TOP_K = 4
D_FF = D_MODEL
SWIGLU_LIMIT = 7.0
SWIGLU_ALPHA = 1.702
MOE_BLOCK = 256
LN_EPS = 1e-5
NEG_INF = -1e30
DEEPNORM_ALPHA = (2.0 * DEPTH) ** 0.25
DEEPNORM_BETA = (8.0 * DEPTH) ** -0.25

kernel_name = "hymba_diffattn_s5_moe_deepnorm"


def layer_norm(x, g, b):
    xf = x.astype(jnp.float32)
    mu = jnp.mean(xf, axis=-1, keepdims=True)
    var = jnp.mean(jnp.square(xf - mu), axis=-1, keepdims=True)
    y = (xf - mu) * lax.rsqrt(var + LN_EPS) * g.astype(jnp.float32) + b.astype(jnp.float32)
    return y.astype(x.dtype)


def rms_norm(x, g):
    xf = x.astype(jnp.float32)
    y = xf * lax.rsqrt(jnp.mean(jnp.square(xf), axis=-1, keepdims=True) + LN_EPS) * g.astype(jnp.float32)
    return y.astype(x.dtype)


def t5_bucket(rel):
    nb = N_BUCKETS // 2
    max_exact = nb // 2
    ret = jnp.where(rel > 0, nb, 0)
    n = jnp.abs(rel)
    n_f = jnp.maximum(n, 1).astype(jnp.float32)
    large = max_exact + (jnp.log(n_f / max_exact) / math.log(MAX_DISTANCE / max_exact)
                         * (nb - max_exact)).astype(jnp.int32)
    large = jnp.minimum(large, nb - 1)
    return ret + jnp.where(n < max_exact, n, large)


def diff_attention(q, k, v, lam, lam_init, rel_bias, subln_g, pos, q_chunk, key_chunk):
    bsz, lp = q.shape[0], q.shape[1]
    qh = jnp.transpose(q, (0, 2, 3, 1, 4)) * (HEAD_DIM ** -0.5)
    kh = jnp.transpose(k, (0, 2, 3, 1, 4))
    vh = jnp.transpose(v, (0, 2, 1, 3))
    table = rel_bias.astype(jnp.float32)
    n_blocks = lp // Q_BLOCK

    def one_block(i):
        start = i * Q_BLOCK
        qb = lax.dynamic_slice_in_dim(qh, start, Q_BLOCK, axis=3)
        qpos = lax.dynamic_slice_in_dim(pos, start, Q_BLOCK)
        qc = lax.dynamic_slice_in_dim(q_chunk, start, Q_BLOCK)
        s = jnp.einsum('bhmqd,bhmkd->bhmqk', qb, kh).astype(jnp.float32)
        bias = table[t5_bucket(pos[None, :] - qpos[:, None])]
        s = s + jnp.transpose(bias, (2, 0, 1))[None, :, None]
        visible = key_chunk[None, :] <= qc[:, None]
        s = jnp.where(visible[None, None, None], s, NEG_INF)
        p = jax.nn.softmax(s, axis=-1)
        w = p[:, :, 0] - lam * p[:, :, 1]
        return jnp.einsum('bhqk,bhke->bqhe', w.astype(vh.dtype), vh)

    o = lax.map(one_block, jnp.arange(n_blocks))
    o = jnp.transpose(o, (1, 0, 2, 3, 4)).reshape(bsz, lp, ATT_HEADS, 2 * HEAD_DIM)
    o = rms_norm(o, subln_g) * (1.0 - lam_init)
    return o.reshape(bsz, lp, ATT_W)


def s5_ssm(u, a_re, a_im, log_step, b_re, b_im, c_re, c_im, d_skip, w_glu, b_glu):
    f32 = jnp.float32
    bsz, lp, _ = u.shape
    uf = u.astype(f32).reshape(bsz, lp, SSM_G, SSM_CG)
    step = jnp.exp(log_step.astype(f32))[:, None]
    ar = jnp.minimum(a_re.astype(f32), -1e-4)
    ai = a_im.astype(f32)
    mag = jnp.exp(step * ar)
    ph = step * ai
    abar_re = mag * jnp.cos(ph)
    abar_im = mag * jnp.sin(ph)
    den = ar * ar + ai * ai
    e_re = abar_re - 1.0
    e_im = abar_im
    f_re = (e_re * ar + e_im * ai) / den
    f_im = (e_im * ar - e_re * ai) / den
    br = b_re.astype(f32)
    bi = b_im.astype(f32)
    bb_re = f_re[..., None] * br - f_im[..., None] * bi
    bb_im = f_re[..., None] * bi + f_im[..., None] * br
    bu_re = jnp.einsum('blgc,gnc->blgn', uf, bb_re)
    bu_im = jnp.einsum('blgc,gnc->blgn', uf, bb_im)
    a_seq_re = jnp.broadcast_to(abar_re[None, None], (1, lp, SSM_G, SSM_N))
    a_seq_im = jnp.broadcast_to(abar_im[None, None], (1, lp, SSM_G, SSM_N))

    def combine(e1, e2):
        a1r, a1i, b1r, b1i = e1
        a2r, a2i, b2r, b2i = e2
        return (a1r * a2r - a1i * a2i,
                a1r * a2i + a1i * a2r,
                a2r * b1r - a2i * b1i + b2r,
                a2r * b1i + a2i * b1r + b2i)

    _, _, xr, xi = lax.associative_scan(combine, (a_seq_re, a_seq_im, bu_re, bu_im), axis=1)
    y = (jnp.einsum('blgn,gcn->blgc', xr, c_re.astype(f32))
         - jnp.einsum('blgn,gcn->blgc', xi, c_im.astype(f32))
         + d_skip.astype(f32).reshape(SSM_G, SSM_CG) * uf)
    y = jax.nn.gelu(y.reshape(bsz, lp, SSM_W))
    y = y * jax.nn.sigmoid(y @ w_glu.astype(f32) + b_glu.astype(f32))
    return y.astype(u.dtype)


def moe_ffn(t, w_router, b_router, w_gate, b_gate, w_up, b_up, w_down, b_down):
    n_tok, dm = t.shape
    logits = t.astype(jnp.float32) @ w_router.astype(jnp.float32) + b_router.astype(jnp.float32)
    top_val, top_idx = lax.top_k(logits, TOP_K)
    gates = jax.nn.softmax(top_val, axis=-1)
    nk = n_tok * TOP_K
    flat_e = top_idx.reshape(nk).astype(jnp.int32)
    order = jnp.argsort(flat_e)
    sorted_e = flat_e[order]
    counts = jnp.bincount(flat_e, length=N_EXPERTS)
    padded = (counts + MOE_BLOCK - 1) // MOE_BLOCK * MOE_BLOCK
    padded_end = jnp.cumsum(padded)
    padded_start = padded_end - padded
    group_start = jnp.cumsum(counts) - counts
    dest = padded_start[sorted_e] + jnp.arange(nk, dtype=jnp.int32) - group_start[sorted_e]
    n_blocks = -(-nk // MOE_BLOCK) + N_EXPERTS
    cap = n_blocks * MOE_BLOCK
    buf_tok = jnp.full((cap,), n_tok, jnp.int32).at[dest].set((order // TOP_K).astype(jnp.int32))
    buf_gate = jnp.zeros((cap,), jnp.float32).at[dest].set(gates.reshape(nk)[order])
    block_expert = jnp.minimum(
        jnp.searchsorted(padded_end, jnp.arange(n_blocks, dtype=jnp.int32) * MOE_BLOCK, side='right'),
        N_EXPERTS - 1)
    t_pad = jnp.concatenate([t, jnp.zeros((1, dm), t.dtype)], axis=0)

    def expert_block(args):
        tok, g, e = args
        xb = t_pad[tok]
        gate = xb @ w_gate[e] + b_gate[e]
        up = xb @ w_up[e] + b_up[e]
        gate = jnp.minimum(gate, SWIGLU_LIMIT)
        up = jnp.clip(up, -SWIGLU_LIMIT, SWIGLU_LIMIT)
        y = ((up + 1.0) * gate * jax.nn.sigmoid(gate * SWIGLU_ALPHA)) @ w_down[e] + b_down[e]
        return (y * g[:, None]).astype(t.dtype)

    out = lax.map(expert_block, (buf_tok.reshape(n_blocks, MOE_BLOCK),
                                 buf_gate.reshape(n_blocks, MOE_BLOCK), block_expert))
    y = jnp.zeros((n_tok + 1, dm), t.dtype).at[buf_tok].add(out.reshape(cap, dm))
    return y[:n_tok]


def setup_inputs(seed: int = 0) -> dict:
    key = jax.random.key(seed)
    ks = jax.random.split(key, 40)
    f32 = jnp.float32

    def nrm(k, shape, s):
        return jax.random.normal(k, shape, f32) * s

    col_scale = jnp.concatenate([jnp.ones((2 * ATT_Q,), f32),
                                 jnp.full((ATT_V,), DEEPNORM_BETA, f32),
                                 jnp.ones((SSM_W,), f32)])
    return {
        'x': nrm(ks[0], (BATCH, SEQ, D_MODEL), 1.0),
        'meta_tokens': nrm(ks[1], (N_META, D_MODEL), 1.0),
        'ln_in_g': 1.0 + nrm(ks[2], (D_MODEL,), 0.02),
        'ln_in_b': nrm(ks[3], (D_MODEL,), 0.02),
        'rel_bias': nrm(ks[4], (N_BUCKETS, ATT_HEADS), 0.3),
        'w_in': nrm(ks[5], (DEPTH, D_MODEL, IN_COLS), D_MODEL ** -0.5) * col_scale,
        'lambda_q1': nrm(ks[6], (DEPTH, HEAD_DIM), 0.1),
        'lambda_k1': nrm(ks[7], (DEPTH, HEAD_DIM), 0.1),
        'lambda_q2': nrm(ks[8], (DEPTH, HEAD_DIM), 0.1),
        'lambda_k2': nrm(ks[9], (DEPTH, HEAD_DIM), 0.1),
        'subln_g': 1.0 + nrm(ks[10], (DEPTH, 2 * HEAD_DIM), 0.02),
        'a_re': -0.5 + nrm(ks[11], (DEPTH, SSM_G, SSM_N), 0.01),
        'a_im': math.pi * jnp.arange(SSM_N, dtype=f32) + nrm(ks[12], (DEPTH, SSM_G, SSM_N), 0.01),
        'log_step': jax.random.uniform(ks[13], (DEPTH, SSM_G), f32, math.log(1e-3), math.log(1e-1)),
        'b_re': nrm(ks[14], (DEPTH, SSM_G, SSM_N, SSM_CG), (2.0 * SSM_CG) ** -0.5),
        'b_im': nrm(ks[15], (DEPTH, SSM_G, SSM_N, SSM_CG), (2.0 * SSM_CG) ** -0.5),
        'c_re': nrm(ks[16], (DEPTH, SSM_G, SSM_CG, SSM_N), SSM_N ** -0.5),
        'c_im': nrm(ks[17], (DEPTH, SSM_G, SSM_CG, SSM_N), SSM_N ** -0.5),
        'd_skip': nrm(ks[18], (DEPTH, SSM_W), 1.0),
        'w_glu': nrm(ks[19], (DEPTH, SSM_W, SSM_W), SSM_W ** -0.5),
        'b_glu': nrm(ks[20], (DEPTH, SSM_W), 0.02),
        'w_out': nrm(ks[21], (DEPTH, D_MIX, D_MODEL), D_MIX ** -0.5 * DEEPNORM_BETA),
        'ln1_g': 1.0 + nrm(ks[22], (DEPTH, D_MODEL), 0.02),
        'ln1_b': nrm(ks[23], (DEPTH, D_MODEL), 0.02),
        'w_router': nrm(ks[24], (DEPTH, D_MODEL, N_EXPERTS), D_MODEL ** -0.5),
        'b_router': nrm(ks[25], (DEPTH, N_EXPERTS), 0.01),
        'w_gate': nrm(ks[26], (DEPTH, N_EXPERTS, D_MODEL, D_FF), D_MODEL ** -0.5),
        'b_gate': nrm(ks[27], (DEPTH, N_EXPERTS, D_FF), 0.02),
        'w_up': nrm(ks[28], (DEPTH, N_EXPERTS, D_MODEL, D_FF), D_MODEL ** -0.5),
        'b_up': nrm(ks[29], (DEPTH, N_EXPERTS, D_FF), 0.02),
        'w_down': nrm(ks[30], (DEPTH, N_EXPERTS, D_FF, D_MODEL), D_FF ** -0.5 * DEEPNORM_BETA),
        'b_down': nrm(ks[31], (DEPTH, N_EXPERTS, D_MODEL), 0.02),
        'ln2_g': 1.0 + nrm(ks[32], (DEPTH, D_MODEL), 0.02),
        'ln2_b': nrm(ks[33], (DEPTH, D_MODEL), 0.02),
    }


def reference(x, meta_tokens, ln_in_g, ln_in_b, rel_bias, w_in, lambda_q1, lambda_k1,
              lambda_q2, lambda_k2, subln_g, a_re, a_im, log_step, b_re, b_im, c_re, c_im,
              d_skip, w_glu, b_glu, w_out, ln1_g, ln1_b, w_router, b_router, w_gate, b_gate,
              w_up, b_up, w_down, b_down, ln2_g, ln2_b):
    f32 = jnp.float32
    bsz, seq, dm = x.shape
    total = N_META + seq
    lp = -(-total // Q_BLOCK) * Q_BLOCK
    h = jnp.concatenate([jnp.broadcast_to(meta_tokens.astype(x.dtype)[None], (bsz, N_META, dm)), x], axis=1)
    h = layer_norm(h, ln_in_g, ln_in_b)
    h = jnp.pad(h, ((0, 0), (0, lp - total), (0, 0)))
    pos = jnp.arange(lp, dtype=jnp.int32)
    chunk = jnp.where(pos < N_META, 0, (pos - N_META) // CHUNK + 1)
    key_chunk = jnp.where(pos < total, chunk, jnp.int32(2 ** 30))

    for l in range(DEPTH):
        proj = h @ w_in[l]
        q = proj[..., :ATT_Q].reshape(bsz, lp, ATT_HEADS, 2, HEAD_DIM)
        k = proj[..., ATT_Q:2 * ATT_Q].reshape(bsz, lp, ATT_HEADS, 2, HEAD_DIM)
        v = proj[..., 2 * ATT_Q:2 * ATT_Q + ATT_V].reshape(bsz, lp, ATT_HEADS, 2 * HEAD_DIM)
        u = proj[..., 2 * ATT_Q + ATT_V:]
        lam_init = 0.8 - 0.6 * math.exp(-0.3 * l)
        lam = (jnp.exp(jnp.sum(lambda_q1[l].astype(f32) * lambda_k1[l].astype(f32)))
               - jnp.exp(jnp.sum(lambda_q2[l].astype(f32) * lambda_k2[l].astype(f32))) + lam_init)
        att = diff_attention(q, k, v, lam, lam_init, rel_bias, subln_g[l], pos, chunk, key_chunk)
        ssm = s5_ssm(u, a_re[l], a_im[l], log_step[l], b_re[l], b_im[l], c_re[l], c_im[l],
                     d_skip[l], w_glu[l], b_glu[l])
        mix = jnp.concatenate([att, ssm], axis=-1) @ w_out[l]
        h = layer_norm(DEEPNORM_ALPHA * h + mix, ln1_g[l], ln1_b[l])
        ffn = moe_ffn(h.reshape(bsz * lp, dm), w_router[l], b_router[l], w_gate[l], b_gate[l],
                      w_up[l], b_up[l], w_down[l], b_down[l]).reshape(bsz, lp, dm)
        h = layer_norm(DEEPNORM_ALPHA * h + ffn, ln2_g[l], ln2_b[l])

    return h[:, N_META:N_META + seq]
```

```cpp
#include <hip/hip_runtime.h>
#include <cstdio>
#include <cstdint>

#define LAS __attribute__((address_space(3)))
#define GAS __attribute__((address_space(1)))
typedef unsigned short bf16;
typedef float f32x4 __attribute__((ext_vector_type(4)));
typedef float f32x2 __attribute__((ext_vector_type(2)));
typedef unsigned u32x4 __attribute__((ext_vector_type(4)));
typedef unsigned u32x2 __attribute__((ext_vector_type(2)));
typedef GAS unsigned gu32;

constexpr int NB = 2, SEQ = 16384, DM = 1024, NMETA = 16;
constexpr int MT = NB * SEQ;
constexpr int XR = 256 + MT;
constexpr int NH = 4, QW = 512;
constexpr int NG = 32, SW = 512;
constexpr int NE = 32;
constexpr int NCH = 2048, CHR = 2304, AK = 384;
constexpr float LN_EPS = 1e-5f;
constexpr float ALPHA = 1.189207115002721f;
constexpr float LOG2E = 1.4426950408889634f;
constexpr float C2 = 0.125f * LOG2E;
constexpr int NIN = 34;
enum { I_X = 0, I_META, I_LNIN_G, I_LNIN_B, I_RELB, I_WIN, I_LQ1, I_LK1, I_LQ2, I_LK2, I_SUBLN, I_ARE, I_AIM, I_LOGSTEP, I_BRE, I_BIM, I_CRE, I_CIM,
       I_DSKIP, I_WGLU, I_BGLU, I_WOUT, I_LN1G, I_LN1B, I_WROUTER, I_BROUTER, I_WGATE, I_BGATE, I_WUP, I_BUP, I_WDOWN, I_BDOWN, I_LN2G, I_LN2B };

constexpr size_t MiB = 1u << 20;
constexpr size_t WS_CTL = 0, CTL_ZERO_BYTES = 32 * 1024;
constexpr size_t WS_PAR = 512 * 1024;
constexpr size_t WS_TOKE = 1 * MiB, WS_TOKG = WS_TOKE + MT * 4 * 4;
constexpr size_t WS_RT2 = 69 * MiB, WS_SD2 = 73 * MiB;
constexpr size_t WS_ROWTOK = 2 * MiB;
constexpr size_t WS_SLOTDST = WS_ROWTOK + 640 * 1024;
constexpr size_t WS_SLOTG = WS_SLOTDST + 512 * 1024;
constexpr size_t WS_CNT = WS_SLOTG + 512 * 1024;
constexpr size_t WS_WD = 4 * MiB;
constexpr size_t WS_H1Q = 36 * MiB;
constexpr size_t WS_SMALLW = 68 * MiB, WS_WTIN = 68 * MiB, WS_WTGLU = 72 * MiB, WS_WTOUT = 73 * MiB, WS_BTE = 75 * MiB, WS_BTY = 79 * MiB;
constexpr size_t WS_XN = 85 * MiB;
constexpr size_t WS_Q = 150 * MiB, WS_K = 183 * MiB, WS_V = 216 * MiB;
static_assert(WS_V - WS_K == WS_K - WS_Q, "Q/K/V equally spaced");
constexpr size_t WS_ASSM = 249 * MiB;
constexpr size_t WS_ATT = 303 * MiB;
constexpr size_t WS_STAT = 68 * MiB;
constexpr size_t WS_A2 = 152 * MiB;
static_assert(WS_A2 >= WS_XN + (size_t)XR * DM * 2 && WS_A2 + ((size_t)MT * 4 + 256) * DM <= WS_ATT + (size_t)MT * DM * 2, "A2 placement");
constexpr size_t WS_X = 389 * MiB;
constexpr size_t WS_END = 517 * MiB;
constexpr size_t DO_E = 0, DO_G = 32 * MiB, DO_BE = 64 * MiB;

constexpr int CW_GTOT = 6144, GTOT_STRIDE = 64;
constexpr int CW_BAR = 1024;
constexpr int PF_LAM = 0, PF_A16 = 64  , PF_A256 = PF_A16 + 4096, PF_SM = PF_A256 + 4096  ;

constexpr int LDS_BYTES = 147456, MISC_OFF = 147456 - 256;

__device__ __forceinline__ float bf2f(unsigned v) { return __uint_as_float(v << 16); }
__device__ __forceinline__ unsigned f2bf(float f) { unsigned u = __float_as_uint(f); return (u + 0x7fffu + ((u >> 16) & 1u)) >> 16; }
typedef float f32x2pk __attribute__((ext_vector_type(2))); typedef __bf16 bf16x2pk __attribute__((ext_vector_type(2)));
__device__ __forceinline__ unsigned pk2(float lo, float hi) { f32x2pk v = {lo, hi}; bf16x2pk b = __builtin_convertvector(v, bf16x2pk); return __builtin_bit_cast(unsigned, b); }
__device__ __forceinline__ float bflo(unsigned w) { return __uint_as_float(w << 16); }
__device__ __forceinline__ float bfhi(unsigned w) { return __uint_as_float(w & 0xffff0000u); }
template <int CTRL> __device__ __forceinline__ float dpp_f(float x) { return __builtin_bit_cast(float, __builtin_amdgcn_update_dpp(0, __builtin_bit_cast(int, x), CTRL, 0xF, 0xF, false)); }
template <int CTRL> __device__ __forceinline__ int dpp_i(int x) { return __builtin_amdgcn_update_dpp(0, x, CTRL, 0xF, 0xF, false); }
constexpr int DPP_XOR1 = 0xB1, DPP_XOR2 = 0x4E, DPP_ROR4 = 0x124, DPP_ROR8 = 0x128, DPP_HMIRROR = 0x141, DPP_MIRROR = 0x140;
__device__ __forceinline__ float wave_sum(float v) {
    v += dpp_f<DPP_XOR1>(v); v += dpp_f<DPP_XOR2>(v); v += dpp_f<DPP_HMIRROR>(v); v += dpp_f<DPP_MIRROR>(v);
    { auto r = __builtin_amdgcn_permlane16_swap(__float_as_uint(v), __float_as_uint(v), false, false); v = __uint_as_float(r[0]) + __uint_as_float(r[1]); }
    { auto r = __builtin_amdgcn_permlane32_swap(__float_as_uint(v), __float_as_uint(v), false, false); v = __uint_as_float(r[0]) + __uint_as_float(r[1]); }
    return v;
}
__device__ __forceinline__ float sigmoidf_(float x) { return __builtin_amdgcn_rcpf(1.0f + __builtin_amdgcn_exp2f(-1.4426950408889634f * x)); }
__device__ __forceinline__ float gelu_tanh(float x) { const float z = 0.7978845608028654f * (x + 0.044715f * x * x * x); const float e = __builtin_amdgcn_exp2f(2.8853900817779268f * z); return x - x * __builtin_amdgcn_rcpf(1.0f + e); }
__device__ __forceinline__ int t5_bucket(int rel) {
    const int n = rel < 0 ? -rel : rel; int b;
    if (n < 8) b = n; else if (n < 12) b = 8; else if (n < 16) b = 9; else if (n < 23) b = 10; else if (n < 32) b = 11; else if (n < 46) b = 12; else if (n < 64) b = 13; else if (n < 91) b = 14; else b = 15;
    return b + (rel > 0 ? 16 : 0);
}

#define XB_TMO      128
#define XB_XCNT(j)  (256  + 64 * (j))
#define XB_XSUB(j)  (1280 + 64 * (j))
#define XB_XGEN(j)  (2304 + 64 * (j))
#define XB_TOP      3328
#define XB_TOPGEN   3392
#define XCD_BAR_WORDS 3456
#define XB_SPIN_CAP (1u << 22)
__device__ __forceinline__ unsigned xb_ld(unsigned* p)              { return __hip_atomic_load(p, __ATOMIC_RELAXED, __HIP_MEMORY_SCOPE_AGENT); }
__device__ __forceinline__ unsigned xb_add(unsigned* p, unsigned v) { return __hip_atomic_fetch_add(p, v, __ATOMIC_RELAXED, __HIP_MEMORY_SCOPE_AGENT); }
__device__ __forceinline__ unsigned xb_xcc_id() { return (unsigned)__builtin_amdgcn_s_getreg((3 << 11) | 20) & 0xFu; }
#define XB_SPIN(cond, bar) do { unsigned _sp = 0; while (cond) { __builtin_amdgcn_s_sleep(1); \
    if ((++_sp & 255u) == 0u) { if (xb_ld(&(bar)[XB_TMO])) break; if (_sp > XB_SPIN_CAP) { atomicAdd(&(bar)[XB_TMO], 1u); break; } } } } while (0)
struct XcdBarrier { unsigned* bar; unsigned x; volatile LAS unsigned* st; };
__device__ __forceinline__ XcdBarrier xcd_barrier_post(unsigned* bar, volatile LAS unsigned* st) {
    XcdBarrier b; b.bar = bar; b.x = xb_xcc_id(); b.st = st;
    if (threadIdx.x == 0) (void)xb_add(&bar[XB_XCNT(b.x)], 1u);
    return b;
}
__device__ __forceinline__ void xcd_barrier_complete(unsigned* bar, unsigned x, unsigned& nloc, unsigned& nx) {
    const unsigned G = gridDim.x * gridDim.y * gridDim.z;
    unsigned sum, cnt, mine, sp = 0u;
    for (;;) {
        sum = 0u; cnt = 0u; mine = 0u;
#pragma unroll
        for (unsigned j = 0; j < 16; ++j) { const unsigned c = xb_ld(&bar[XB_XCNT(j)]); sum += c; cnt += (c > 0u) ? 1u : 0u; mine = (j == x) ? c : mine; }
        if (sum == G) break;
        __builtin_amdgcn_s_sleep(1);
        if ((++sp & 255u) == 0u) { if (xb_ld(&bar[XB_TMO])) break; if (sp > XB_SPIN_CAP) { atomicAdd(&bar[XB_TMO], 1u); break; } }
    }
    nloc = mine > 0u ? mine : 1u; nx = cnt > 0u ? cnt : 1u;
}
__device__ __forceinline__ void xcd_barrier(const XcdBarrier& b) {
    asm volatile("s_waitcnt vmcnt(0)" ::: "memory");
    __syncthreads();
    if (threadIdx.x == 0) {
        unsigned* bar = b.bar;
        __builtin_amdgcn_s_waitcnt(0);
        unsigned nloc = b.st[0], nx = b.st[1];
        if (nloc == 0u) { xcd_barrier_complete(bar, b.x, nloc, nx); b.st[0] = nloc; b.st[1] = nx; }
        const unsigned old = xb_add(&bar[XB_XSUB(b.x)], 1u);
        const unsigned gen = old / nloc;
        if (old + 1u == (gen + 1u) * nloc) {
            __builtin_amdgcn_fence(__ATOMIC_RELEASE, "agent");
            asm volatile("s_waitcnt vmcnt(0)" ::: "memory");
            const unsigned og = xb_add(&bar[XB_TOP], 1u);
            const unsigned tg = og / nx;
            if (og + 1u == (tg + 1u) * nx) xb_add(&bar[XB_TOPGEN], 1u);
            else XB_SPIN(xb_ld(&bar[XB_TOPGEN]) == tg, bar);
            __builtin_amdgcn_fence(__ATOMIC_ACQUIRE, "agent");
            xb_add(&bar[XB_XGEN(b.x)], 1u);
            asm volatile("s_waitcnt vmcnt(0)" ::: "memory");
        } else {
            XB_SPIN(xb_ld(&bar[XB_XGEN(b.x)]) == gen, bar);
            __builtin_amdgcn_fence(__ATOMIC_ACQUIRE, "agent");
            asm volatile("s_waitcnt vmcnt(0)" ::: "memory");
        }
    }
    __syncthreads();
}

struct Args { const float* in[NIN]; float* out; unsigned char* ws; int ph_lo, ph_hi; };
struct Frame {
    LAS unsigned char* lds;
    const float* const* in; float* out; unsigned char* ws;
    int wave, vcu, G;
};
#define WSP(T, off) ((T*)(F.ws + (off)))


namespace pg8 {
typedef short bf16x8 __attribute__((ext_vector_type(8)));
constexpr int BM = 256, BK = 64, HALF = 128, HTB = HALF * BK * 2, STAGE_BYTES = 8 * HTB, NXCD = 8, WGM = 8;
__host__ __device__ __forceinline__ int lds_byte(int r, int c) { const int st = (r >> 4) * 2 + (c >> 5), rr = r & 15, cc = c & 31, ob = rr * 64 + cc * 2; return st * 1024 + (ob ^ (((ob >> 9) & 1) << 5)); }
__host__ __device__ __forceinline__ void stage_rc(int b, int& R, int& C) { const int st = b / 1024, sb = b % 1024, swz = sb ^ (((sb >> 9) & 1) << 5); R = (st >> 1) * 16 + swz / 64; C = (st & 1) * 32 + (swz % 64) / 2; }
__host__ __device__ __forceinline__ int perm32(int rho) { const int n = rho >> 4, i = rho & 15; return 8 * (i >> 2) + 4 * n + (i & 3); }
__device__ __forceinline__ unsigned cvt_pk_bf16(float lo, float hi) { unsigned r; asm volatile("v_cvt_pk_bf16_f32 %0, %1, %2" : "=v"(r) : "v"(lo), "v"(hi)); return r; }

struct GUnit { const char* A; const char* B; int i0, i1, i2, i3, i4; };
struct TileOrder {
    int nM, nN, nwg, G, c;
    __device__ void init(int nM_, int nN_, int G_, int c_) { nM = nM_; nN = nN_; nwg = nM * nN; G = G_; c = c_; }
    __device__ bool next(int i, int& pm, int& pn) const {
        const long L = (long)i * G + c; if (L >= nwg) return false;
        int wgid = (int)L; { const int q = nwg / NXCD, r = nwg % NXCD, xcd = wgid % NXCD, off = wgid / NXCD; wgid = (xcd < r ? xcd * (q + 1) : r * (q + 1) + (xcd - r) * q) + off; }
        const int nig = WGM * nN, gid = wgid / nig, fm = gid * WGM, gsz = (nM - fm) < WGM ? (nM - fm) : WGM;
        pm = fm + ((wgid % nig) % gsz); pn = (wgid % nig) / gsz; return true;
    }
};
typedef int v4i_t __attribute__((ext_vector_type(4))); typedef int v8i_t __attribute__((ext_vector_type(8)));
template <class Epi, class Sched, bool ALIGN_EPI, bool FP8 = false>
__device__ __forceinline__ void gemm_phase(LAS unsigned char* lds, const int KB, const Sched& S, const Epi& E) {
    const int tid = threadIdx.x, wid = __builtin_amdgcn_readfirstlane(tid >> 6), lane = tid & 63, wr = wid >> 2, wc = wid & 3, fr = lane & 15, fq = lane >> 4;
    const int nt = KB / 128;
    unsigned voffB[2];
#pragma unroll
    for (int i = 0; i < 2; ++i) { int R, C; stage_rc(tid * 16 + i * 8192, R, C); const int Rb = Epi::PERM ? ((R & ~31) + perm32(R & 31)) : R; voffB[i] = (unsigned)(Rb * KB + C * 2); }
    const unsigned lda2 = (unsigned)S.ldab;
#define PG8_VOFFA_N(dst, un, tbn) do { _Pragma("unroll") for (int _i = 0; _i < 2; ++_i) { int _R, _C; stage_rc(tid * 16 + _i * 8192, _R, _C); \
        _Pragma("unroll") for (int _h = 0; _h < 2; ++_h) dst[_h][_i] = (unsigned)S.arow_next(un, _h * HALF + _R, lds, (tbn)) * lda2 + (unsigned)_C * 2u; } } while (0)
#define PG8_VOFFA(dst, un) do { _Pragma("unroll") for (int _i = 0; _i < 2; ++_i) { int _R, _C; stage_rc(tid * 16 + _i * 8192, _R, _C); \
        _Pragma("unroll") for (int _h = 0; _h < 2; ++_h) dst[_h][_i] = (unsigned)S.arow(un, _h * HALF + _R) * lda2 + (unsigned)_C * 2u; } } while (0)
    const size_t kstep = (size_t)(BK * 2);
    const size_t hstep = (size_t)HALF * KB;
    const unsigned ldsw = (unsigned)wid * 1024u;
    const int aoff = lds_byte(wr * 64 + fr, fq * 8), boff = lds_byte(wc * 32 + fr, fq * 8);
#define PG8_SA(b, h) (((b) * 2 + (h)) * HTB)
#define PG8_SB(b, h) ((4 + (b) * 2 + (h)) * HTB)
#define PG8_STAGE(bufoff, gbase, voff) do { _Pragma("unroll") for (int _i = 0; _i < 2; ++_i) \
        __builtin_amdgcn_global_load_lds((const unsigned*)((const char*)(gbase) + (voff)[_i]), (LAS unsigned*)(lds + (bufoff) + ldsw + _i * 8192), 16, 0, 0); } while (0)
#define PG8_LDA(dst, b, h) do { _Pragma("unroll") for (int m = 0; m < 4; ++m) _Pragma("unroll") for (int k = 0; k < 2; ++k) dst[m][k] = *(const LAS bf16x8*)(lds + PG8_SA(b, h) + aoff + m * 2048 + k * 1024); } while (0)
#define PG8_LDB(dst, b, h) do { _Pragma("unroll") for (int n = 0; n < 2; ++n) _Pragma("unroll") for (int k = 0; k < 2; ++k) dst[n][k] = *(const LAS bf16x8*)(lds + PG8_SB(b, h) + boff + n * 2048 + k * 1024); } while (0)
#define PG8_CAT(x) __builtin_shufflevector(__builtin_bit_cast(v4i_t, x[0]), __builtin_bit_cast(v4i_t, x[1]), 0, 1, 2, 3, 4, 5, 6, 7)
#define PG8_MMA(ai, bj, At, Bt) do { __builtin_amdgcn_s_setprio(1); _Pragma("unroll") for (int m = 0; m < 4; ++m) _Pragma("unroll") for (int n = 0; n < 2; ++n) { \
        if constexpr (FP8) { const v8i_t b8_ = PG8_CAT(Bt[n]), a8_ = PG8_CAT(At[m]);   \
            asm volatile("v_mfma_scale_f32_16x16x128_f8f6f4 %0, %1, %2, %0, %3, %4 op_sel_hi:[0,0,0]" : "+v"(acc[ai][bj][m][n]) : "v"(b8_), "v"(a8_), "v"(sclW), "v"(sclX)); } \
        else { _Pragma("unroll") for (int k = 0; k < 2; ++k) acc[ai][bj][m][n] = __builtin_amdgcn_mfma_f32_16x16x32_bf16(Bt[n][k], At[m][k], acc[ai][bj][m][n], 0, 0, 0); } } \
        __builtin_amdgcn_s_setprio(0); } while (0)
#define PG8_WAIT_V(n) asm volatile("s_waitcnt vmcnt(" #n ")" ::: "memory")
#define PG8_WAIT_L(n) asm volatile("s_waitcnt lgkmcnt(" #n ")" ::: "memory")
#define PG8_BAR __builtin_amdgcn_s_barrier()
#define PG8_SCHED __builtin_amdgcn_sched_barrier(0)
    const int sclW = 122, sclX = 127;
    GUnit cur; int ui = 0;
    if (!S.next(0, cur)) return;
    int tb = 0;
    if constexpr (Epi::PREFETCH) E.prefetch(lds, cur, 0, wid, lane);
    unsigned voffA[2][2], nvoffA[2][2];
    PG8_VOFFA(voffA, cur);
    f32x4 acc[2][2][4][2];
#pragma unroll
    for (int a = 0; a < 2; ++a)
#pragma unroll
        for (int b = 0; b < 2; ++b)
#pragma unroll
            for (int m = 0; m < 4; ++m)
#pragma unroll
                for (int n = 0; n < 2; ++n) acc[a][b][m][n] = (f32x4){0.f, 0.f, 0.f, 0.f};
    bf16x8 At[4][2], B0[2][2], B1[2][2];
    const char* cA = cur.A; const char* cB = cur.B;
    PG8_STAGE(PG8_SB(0, 0), cB, voffB); PG8_STAGE(PG8_SB(0, 1), cB + hstep, voffB); PG8_STAGE(PG8_SA(0, 0), cA, voffA[0]); PG8_STAGE(PG8_SA(0, 1), cA, voffA[1]);
    if (wr == 1) PG8_BAR;
    PG8_WAIT_V(2); PG8_BAR;
    PG8_STAGE(PG8_SB(1, 0), cB + kstep, voffB); PG8_STAGE(PG8_SA(1, 0), cA + kstep, voffA[0]); PG8_STAGE(PG8_SB(1, 1), cB + hstep + kstep, voffB);
    PG8_WAIT_V(6); PG8_BAR;
    for (;;) {
        const char* nA = cA; const char* nB = cB; bool has_next;
        GUnit nxt; has_next = S.next(ui + 1, nxt);
        if (has_next) { nA = nxt.A; nB = nxt.B; if constexpr (Epi::PREFETCH) E.prefetch(lds, nxt, tb == 2 ? 0 : tb + 1, wid, lane); }
#pragma unroll
        for (int h = 0; h < 2; ++h)
#pragma unroll
            for (int i = 0; i < 2; ++i) nvoffA[h][i] = voffA[h][i];
#pragma nounroll
        for (int t = 0; t < nt; t += 2) {
            const bool last = (t == nt - 2);
            if (last && has_next) { PG8_VOFFA_N(nvoffA, nxt, (tb == 2 ? 0 : tb + 1)); }
            const char* a1 = cA + (size_t)(t + 1) * kstep;
            const char* a2 = last ? nA : cA + (size_t)(t + 2) * kstep; const char* b2 = last ? nB : cB + (size_t)(t + 2) * kstep;
            const char* a3 = a2 + kstep; const char* b3 = b2 + kstep;
            unsigned vA2[2][2];
#pragma unroll
            for (int h = 0; h < 2; ++h)
#pragma unroll
                for (int i = 0; i < 2; ++i) vA2[h][i] = last ? nvoffA[h][i] : voffA[h][i];
            PG8_LDB(B0, 0, 0); PG8_LDB(B1, 0, 1); PG8_SCHED; PG8_LDA(At, 0, 0); PG8_STAGE(PG8_SA(1, 1), a1, voffA[1]);
            PG8_WAIT_V(8); PG8_WAIT_L(0); PG8_BAR; PG8_MMA(0, 0, At, B0); PG8_MMA(0, 1, At, B1); PG8_BAR; PG8_SCHED;
            PG8_LDA(At, 0, 1); PG8_STAGE(PG8_SB(0, 0), b2, voffB); PG8_STAGE(PG8_SB(0, 1), b2 + hstep, voffB); PG8_STAGE(PG8_SA(0, 0), a2, vA2[0]);
            PG8_WAIT_V(8); PG8_WAIT_L(0); PG8_BAR; PG8_MMA(1, 0, At, B0); PG8_MMA(1, 1, At, B1); PG8_BAR; PG8_SCHED;
            PG8_LDB(B0, 1, 0); PG8_LDB(B1, 1, 1); PG8_SCHED; PG8_LDA(At, 1, 0); PG8_STAGE(PG8_SA(0, 1), a2, vA2[1]);
            PG8_WAIT_V(8); PG8_WAIT_L(0); PG8_BAR; PG8_MMA(0, 0, At, B0); PG8_MMA(0, 1, At, B1); PG8_BAR; PG8_SCHED;
            PG8_LDA(At, 1, 1); PG8_STAGE(PG8_SB(1, 0), b3, voffB); PG8_STAGE(PG8_SB(1, 1), b3 + hstep, voffB); PG8_STAGE(PG8_SA(1, 0), a3, vA2[0]);
            PG8_WAIT_V(8); PG8_WAIT_L(0); PG8_BAR; PG8_MMA(1, 0, At, B0); PG8_MMA(1, 1, At, B1); PG8_BAR; PG8_SCHED;
        }
        if constexpr (FP8) { asm volatile("s_nop 15\n\ts_nop 15" ::: "memory"); PG8_SCHED; }
        if constexpr (ALIGN_EPI) { if (wr == 0) PG8_BAR; }
        if constexpr (Epi::PREFETCH) E(acc, cur, wr, wc, fr, fq, lds, tb); else E(acc, cur, wr, wc, fr, fq);
        if (!has_next) break;
        tb = (tb == 2) ? 0 : tb + 1;
#pragma unroll
        for (int a = 0; a < 2; ++a)
#pragma unroll
            for (int b = 0; b < 2; ++b)
#pragma unroll
                for (int m = 0; m < 4; ++m)
#pragma unroll
                    for (int n = 0; n < 2; ++n) acc[a][b][m][n] = (f32x4){0.f, 0.f, 0.f, 0.f};
        ++ui; (void)S.next(ui, cur); cA = nA; cB = nB;
#pragma unroll
        for (int h = 0; h < 2; ++h)
#pragma unroll
            for (int i = 0; i < 2; ++i) voffA[h][i] = nvoffA[h][i];
        if constexpr (ALIGN_EPI) { if (wr == 1) PG8_BAR; }
    }
    PG8_WAIT_V(0);
    if constexpr (!ALIGN_EPI) { if (wr == 0) PG8_BAR; }
    PG8_BAR;
#undef PG8_VOFFA
#undef PG8_VOFFA_N
#undef PG8_SA
#undef PG8_SB
#undef PG8_STAGE
#undef PG8_LDA
#undef PG8_LDB
#undef PG8_MMA
#undef PG8_CAT
#undef PG8_WAIT_V
#undef PG8_WAIT_L
#undef PG8_BAR
#undef PG8_SCHED
}
}
using pg8::GUnit;

struct DenseSched {
    pg8::TileOrder ord; const char* A; const char* Bt; int lda, K, rowoff, ldab;
    __device__ __forceinline__ bool next(int i, GUnit& u) const { int pm, pn; if (!ord.next(i, pm, pn)) return false; u.A = A; u.B = Bt + (size_t)pn * 256 * K * 2; u.i0 = pm; u.i1 = pn; u.i2 = 0; u.i3 = 0; u.i4 = 0; return true; }
    __device__ __forceinline__ int arow(const GUnit& u, int r) const { return u.i0 * 256 + r + rowoff; }
    __device__ __forceinline__ int arow_next(const GUnit& u, int r, const LAS unsigned char*, int) const { return arow(u, r); }
};

__device__ __forceinline__ void ln_row_bf16(const float* xrow, const float* g, const float* bt, bf16* orow, int lane) {
    const f32x4* xr = (const f32x4*)xrow + lane;
    f32x4 v[4]; float s = 0.f;
#pragma unroll
    for (int j = 0; j < 4; ++j) { v[j] = __builtin_nontemporal_load(xr + 64 * j); s += (v[j].x + v[j].y) + (v[j].z + v[j].w); }
    const float mean = wave_sum(s) * (1.f / DM); float s2 = 0.f;
#pragma unroll
    for (int j = 0; j < 4; ++j) { v[j] = v[j] - mean; s2 += (v[j].x * v[j].x + v[j].y * v[j].y) + (v[j].z * v[j].z + v[j].w * v[j].w); }
    const float rstd = rsqrtf(wave_sum(s2) * (1.f / DM) + LN_EPS);
    u32x2* o8 = (u32x2*)orow + lane;
#pragma unroll
    for (int j = 0; j < 4; ++j) {
        const f32x4 gg = ((const f32x4*)g)[lane + 64 * j], bb = ((const f32x4*)bt)[lane + 64 * j];
        const f32x4 y = v[j] * rstd * gg + bb;
        u32x2 w; w.x = pk2(y.x, y.y); w.y = pk2(y.z, y.w); o8[64 * j] = w;
    }
}

__device__ __forceinline__ void p0_transpose_item(const float* W, int ldw, int k0, int n0, bf16* WT, int ldt, int drow0, LAS float* scr, int lane) {
    {
        f32x4 v[8];
#pragma unroll
        for (int i = 0; i < 8; ++i) v[i] = __builtin_nontemporal_load((const f32x4*)(W + (size_t)(k0 + 8 * i + (lane >> 3)) * ldw + n0 + (lane & 7) * 4));
#pragma unroll
        for (int i = 0; i < 8; ++i) { LAS float* d = scr + (8 * i + (lane >> 3)) * 33 + (lane & 7) * 4; d[0] = v[i].x; d[1] = v[i].y; d[2] = v[i].z; d[3] = v[i].w; }
    }
    asm volatile("s_waitcnt lgkmcnt(0)" ::: "memory");
    const int c = lane & 7;
#pragma unroll
    for (int j = 0; j < 4; ++j) { const int n = (lane >> 3) + 8 * j; const LAS float* sp = scr + (8 * c) * 33 + n;
        u32x4 o; o.x = pk2(sp[0 * 33], sp[1 * 33]); o.y = pk2(sp[2 * 33], sp[3 * 33]); o.z = pk2(sp[4 * 33], sp[5 * 33]); o.w = pk2(sp[6 * 33], sp[7 * 33]);
        __builtin_nontemporal_store(o, (u32x4*)(WT + (size_t)(drow0 + n) * ldt + k0 + 8 * c)); }
    asm volatile("s_waitcnt lgkmcnt(0)" ::: "memory");
}
__device__ __forceinline__ void p0_transpose_item_fp8(const float* W, int ldw, int k0, int n0, unsigned char* WT, int ldt, int drow0, LAS float* scr, int lane) {
    {   f32x4 v[16];
#pragma unroll
        for (int i = 0; i < 16; ++i) v[i] = __builtin_nontemporal_load((const f32x4*)(W + (size_t)(k0 + 8 * i + (lane >> 3)) * ldw + n0 + (lane & 7) * 4));
#pragma unroll
        for (int i = 0; i < 16; ++i) { LAS float* d = scr + (8 * i + (lane >> 3)) * 33 + (lane & 7) * 4; d[0] = v[i].x * 32.0f; d[1] = v[i].y * 32.0f; d[2] = v[i].z * 32.0f; d[3] = v[i].w * 32.0f; }
    }
    asm volatile("s_waitcnt lgkmcnt(0)" ::: "memory");
    const int c = lane & 7;
#pragma unroll
    for (int j = 0; j < 4; ++j) { const int n = (lane >> 3) + 8 * j; const LAS float* sp = scr + (16 * c) * 33 + n;
        u32x4 o;
        o.x = __builtin_amdgcn_cvt_pk_fp8_f32(sp[0 * 33], sp[1 * 33], 0, false);   o.x = __builtin_amdgcn_cvt_pk_fp8_f32(sp[2 * 33], sp[3 * 33], o.x, true);
        o.y = __builtin_amdgcn_cvt_pk_fp8_f32(sp[4 * 33], sp[5 * 33], 0, false);   o.y = __builtin_amdgcn_cvt_pk_fp8_f32(sp[6 * 33], sp[7 * 33], o.y, true);
        o.z = __builtin_amdgcn_cvt_pk_fp8_f32(sp[8 * 33], sp[9 * 33], 0, false);   o.z = __builtin_amdgcn_cvt_pk_fp8_f32(sp[10 * 33], sp[11 * 33], o.z, true);
        o.w = __builtin_amdgcn_cvt_pk_fp8_f32(sp[12 * 33], sp[13 * 33], 0, false); o.w = __builtin_amdgcn_cvt_pk_fp8_f32(sp[14 * 33], sp[15 * 33], o.w, true);
        __builtin_nontemporal_store(o, (u32x4*)(WT + (size_t)(drow0 + n) * ldt + k0 + 16 * c)); }
    asm volatile("s_waitcnt lgkmcnt(0)" ::: "memory");
}
__device__ __forceinline__ void p0_weights(Frame& F) {
    LAS float* scr = (LAS float*)(F.lds + F.wave * 17408);
    const int lane = (int)(threadIdx.x & 63u);
    const int gw = F.vcu * 8 + F.wave, NGW = F.G * 8;
    constexpr int NEXP = 96 * 256, NALL = NEXP + 1024 + 128 + 512;
    for (int it = gw; it < NALL; it += NGW) {
        if (it < NEXP) {
            const int mat = it >> 8, r = it & 255, e = mat / 3, which = mat % 3, kb = r >> 5, nb = r & 31, n0 = nb * 32;
            if (which == 0)      p0_transpose_item_fp8(F.in[I_WGATE] + (size_t)e * DM * DM, DM, kb * 128, n0, F.ws + WS_X + (size_t)e * 2048 * DM, DM, (n0 >> 7) * 256 + (n0 & 127), scr, lane);
            else if (which == 1) p0_transpose_item_fp8(F.in[I_WUP] + (size_t)e * DM * DM, DM, kb * 128, n0, F.ws + WS_X + (size_t)e * 2048 * DM, DM, (n0 >> 7) * 256 + 128 + (n0 & 127), scr, lane);
            else                 p0_transpose_item_fp8(F.in[I_WDOWN] + (size_t)e * DM * DM, DM, kb * 128, n0, F.ws + WS_WD + (size_t)e * DM * DM, DM, n0, scr, lane);
        } else {
            int r = it - NEXP;
            if (r < 1024) { const int kb = r >> 6, nb = r & 63; p0_transpose_item(F.in[I_WIN], 2048, kb * 64, nb * 32, WSP(bf16, WS_WTIN), DM, nb * 32, scr, lane); continue; } r -= 1024;
            if (r < 128) { const int kb = r >> 4, nb = r & 15; p0_transpose_item(F.in[I_WGLU], SW, kb * 64, nb * 32, WSP(bf16, WS_WTGLU), SW, nb * 32, scr, lane); continue; } r -= 128;
            { const int kb = r >> 5, nb = r & 31; p0_transpose_item(F.in[I_WOUT], DM, kb * 64, nb * 32, WSP(bf16, WS_WTOUT), DM, nb * 32, scr, lane); }
        }
    }
}

__device__ __forceinline__ void cpow(float step, float ar, float ai, int d, float& re, float& im) {
    const float mag = __expf((float)d * step * ar);
    const double rev = (double)d * (double)step * (double)ai * 0.15915494309189535; const float fr = (float)(rev - __builtin_floor(rev + 0.5));
    re = mag * __builtin_amdgcn_cosf(fr); im = mag * __builtin_amdgcn_sinf(fr);
}
__device__ __forceinline__ void p0_ssm_tables(Frame& F, int g) {
    LAS float* Pw = (LAS float*)F.lds;
    LAS float* Bb = Pw + 64 * 17 * 2;
    LAS float* Cc = Bb + 64 * 16 * 2;
    LAS float* Md = Cc + 16 * 64 * 2;
    float* PAR = WSP(float, WS_PAR);
    __syncthreads();
    if (((int)threadIdx.x) < 64) {
        const int n = ((int)threadIdx.x), gn = g * 64 + n;
        const float step = __expf(F.in[I_LOGSTEP][g]);
        const float ar = fminf(F.in[I_ARE][gn], -1e-4f), ai = F.in[I_AIM][gn];
        for (int d = 0; d <= 16; ++d) { float re, im; cpow(step, ar, ai, d, re, im); Pw[(n * 17 + d) * 2] = re; Pw[(n * 17 + d) * 2 + 1] = im; }
        float abr, abi; cpow(step, ar, ai, 1, abr, abi);
        const float den = ar * ar + ai * ai, ere = abr - 1.0f, eim = abi;
        const float fre = (ere * ar + eim * ai) / den, fim = (eim * ar - ere * ai) / den;
        for (int c = 0; c < 16; ++c) { const float br = F.in[I_BRE][gn * 16 + c], bi = F.in[I_BIM][gn * 16 + c];
            Bb[(n * 16 + c) * 2] = fre * br - fim * bi; Bb[(n * 16 + c) * 2 + 1] = fre * bi + fim * br; }
        float re, im; cpow(step, ar, ai, 16, re, im); PAR[PF_A16 + gn * 2] = re; PAR[PF_A16 + gn * 2 + 1] = im;
        cpow(step, ar, ai, 256, re, im); PAR[PF_A256 + gn * 2] = re; PAR[PF_A256 + gn * 2 + 1] = im;
    }
    for (int i = ((int)threadIdx.x); i < 1024; i += 512) { Cc[i * 2] = F.in[I_CRE][g * 1024 + i]; Cc[i * 2 + 1] = F.in[I_CIM][g * 1024 + i]; }
    __syncthreads();
    {
        const int d = ((int)threadIdx.x) >> 5, c = (((int)threadIdx.x) >> 1) & 15, h = ((int)threadIdx.x) & 1; float acc[8];
#pragma unroll
        for (int j = 0; j < 8; ++j) acc[j] = 0.f;
        for (int n = 0; n < 64; ++n) { const float cr = Cc[(c * 64 + n) * 2], ci = Cc[(c * 64 + n) * 2 + 1], pr = Pw[(n * 17 + d) * 2], pi = Pw[(n * 17 + d) * 2 + 1];
            const float qr = cr * pr - ci * pi, qi = cr * pi + ci * pr; const LAS float* bb = Bb + (n * 16 + h * 8) * 2;
#pragma unroll
            for (int j = 0; j < 8; ++j) acc[j] += qr * bb[2 * j] - qi * bb[2 * j + 1]; }
#pragma unroll
        for (int j = 0; j < 8; ++j) { const int cp = h * 8 + j; Md[(d * 16 + c) * 16 + cp] = acc[j] + ((d == 0 && c == cp) ? F.in[I_DSKIP][g * 16 + c] : 0.f); }
    }
    __syncthreads();
    {
        const int R = ((int)threadIdx.x) >> 1, i = R >> 4, c = R & 15, k0 = (((int)threadIdx.x) & 1) * 192; bf16* dst = WSP(bf16, WS_BTY) + ((size_t)g * 256 + R) * AK + k0;
        for (int q = 0; q < 24; ++q) { float v[8];
#pragma unroll
            for (int e = 0; e < 8; ++e) { const int k = k0 + q * 8 + e; float val;
                if (k < 256) { const int j = k >> 4, cp = k & 15; val = (j <= i) ? Md[((i - j) * 16 + c) * 16 + cp] : 0.f; }
                else { const int n = (k - 256) & 63; const float cr = Cc[(c * 64 + n) * 2], ci = Cc[(c * 64 + n) * 2 + 1], pr = Pw[(n * 17 + i + 1) * 2], pi = Pw[(n * 17 + i + 1) * 2 + 1];
                    val = (k < 320) ? (cr * pr - ci * pi) : -(cr * pi + ci * pr); }
                v[e] = val; }
            u32x4 w; w.x = pk2(v[0], v[1]); w.y = pk2(v[2], v[3]); w.z = pk2(v[4], v[5]); w.w = pk2(v[6], v[7]); *(u32x4*)(dst + q * 8) = w; }
    }
    {
        const int R = ((int)threadIdx.x) >> 1, n = R & 63, k0 = (((int)threadIdx.x) & 1) * 128; bf16* dst = WSP(bf16, WS_BTE) + ((size_t)g * 256 + R) * 256 + k0;
        for (int q = 0; q < 16; ++q) { float v[8];
#pragma unroll
            for (int e = 0; e < 8; ++e) { const int k = k0 + q * 8 + e, j = k >> 4, cp = k & 15;
                const float pr = Pw[(n * 17 + 15 - j) * 2], pi = Pw[(n * 17 + 15 - j) * 2 + 1], br = Bb[(n * 16 + cp) * 2], bi = Bb[(n * 16 + cp) * 2 + 1];
                v[e] = (R < 64) ? (pr * br - pi * bi) : (R < 128) ? (pr * bi + pi * br) : 0.f; }
            u32x4 w; w.x = pk2(v[0], v[1]); w.y = pk2(v[2], v[3]); w.z = pk2(v[4], v[5]); w.w = pk2(v[6], v[7]); *(u32x4*)(dst + q * 8) = w; }
    }
    __syncthreads();
}
__device__ __forceinline__ void p0_prologue(Frame& F) {
    p0_weights(F);
    if ((F.vcu & 7) == 0) p0_ssm_tables(F, F.vcu >> 3);
    else {
        const int lane = (int)(threadIdx.x & 63u), gwp = (F.vcu - (F.vcu >> 3) - 1) * 8 + F.wave, NGWP = (F.G - F.G / 8) * 8, nrow = NMETA + MT;
        const float* xb = F.in[I_X]; const long moff = (long)(F.in[I_META] - F.in[I_X]);
        bf16* XN = WSP(bf16, WS_XN);
        f32x4 nx[4];
        if (gwp < nrow) { const f32x4* xr = (const f32x4*)(xb + ((gwp < NMETA) ? moff + (long)gwp * DM : (long)(gwp - NMETA) * DM)) + lane;
#pragma unroll
            for (int j = 0; j < 4; ++j) nx[j] = __builtin_nontemporal_load(xr + 64 * j); }
        for (int q = gwp; q < nrow; q += NGWP) {
            f32x4 v[4]; float s = 0.f;
#pragma unroll
            for (int j = 0; j < 4; ++j) { v[j] = nx[j]; s += (v[j].x + v[j].y) + (v[j].z + v[j].w); }
            const int qn = q + NGWP;
            if (qn < nrow) { const f32x4* xr = (const f32x4*)(xb + ((qn < NMETA) ? moff + (long)qn * DM : (long)(qn - NMETA) * DM)) + lane;
#pragma unroll
                for (int j = 0; j < 4; ++j) nx[j] = __builtin_nontemporal_load(xr + 64 * j); }
            const float mean = wave_sum(s) * (1.f / DM); float s2 = 0.f;
#pragma unroll
            for (int j = 0; j < 4; ++j) { v[j] = v[j] - mean; s2 += (v[j].x * v[j].x + v[j].y * v[j].y) + (v[j].z * v[j].z + v[j].w * v[j].w); }
            const float rstd = rsqrtf(wave_sum(s2) * (1.f / DM) + LN_EPS);
            u32x2* o8 = (u32x2*)(XN + (size_t)((q < NMETA) ? q : q + (256 - NMETA)) * DM) + lane;
#pragma unroll
            for (int j = 0; j < 4; ++j) { const f32x4 gg = ((const f32x4*)F.in[I_LNIN_G])[lane + 64 * j], bb = ((const f32x4*)F.in[I_LNIN_B])[lane + 64 * j];
                const f32x4 y = v[j] * rstd * gg + bb; u32x2 w; w.x = pk2(y.x, y.y); w.y = pk2(y.z, y.w); o8[64 * j] = w; }
        }
    }
    float* PAR = WSP(float, WS_PAR);
    if (blockIdx.x == 0 && ((int)threadIdx.x) == 0) {
        float s1 = 0.f, s2 = 0.f;
        for (int i = 0; i < 64; ++i) { s1 += F.in[I_LQ1][i] * F.in[I_LK1][i]; s2 += F.in[I_LQ2][i] * F.in[I_LK2][i]; }
        PAR[PF_LAM] = expf(s1) - expf(s2) + 0.2f;
    }
    if (blockIdx.x == 1 && ((int)threadIdx.x) < 256) WSP(int, WS_ROWTOK)[MT * 4 + ((int)threadIdx.x)] = 0;
}


constexpr float VSCALE = 4.0f;
struct EpiInProj {
    static constexpr bool PERM = true; static constexpr bool PREFETCH = false; bf16 *Q, *Kb, *V, *AS;
    __device__ __forceinline__ void operator()(const f32x4 (&acc)[2][2][4][2], const GUnit& u, int wr, int wc, int fr, int fq) const {
        const int pm = u.i0, pn = u.i1, sel = pn >> 1, colb = (pn & 1) * 256 + wc * 32 + 8 * fq;
        const float sc = (sel == 0) ? C2 : 1.0f;
#pragma unroll
        for (int ai = 0; ai < 2; ++ai)
#pragma unroll
            for (int m = 0; m < 4; ++m) {
                const int r = 256 + pm * 256 + ai * 128 + wr * 64 + m * 16 + fr;
                const int ch = (r - 256) >> 4, j = (r - 256) & 15;
#pragma unroll
                for (int bj = 0; bj < 2; ++bj) {
                    const f32x4 v0 = acc[ai][bj][m][0] * sc, v1 = acc[ai][bj][m][1] * sc; const int c = colb + bj * 128;
                    u32x4 w; w.x = pg8::cvt_pk_bf16(v0[0], v0[1]); w.y = pg8::cvt_pk_bf16(v0[2], v0[3]); w.z = pg8::cvt_pk_bf16(v1[0], v1[1]); w.w = pg8::cvt_pk_bf16(v1[2], v1[3]);
                    if (sel < 2) { bf16* base = Q + (size_t)sel * ((WS_K - WS_Q) / 2); *(u32x4*)(base + (size_t)r * QW + c) = w; }
                    else if (sel == 2) { u32x2 q8; q8.x = __builtin_amdgcn_cvt_pk_fp8_f32(v0[0] * VSCALE, v0[1] * VSCALE, 0, false); q8.x = __builtin_amdgcn_cvt_pk_fp8_f32(v0[2] * VSCALE, v0[3] * VSCALE, q8.x, true);
                        q8.y = __builtin_amdgcn_cvt_pk_fp8_f32(v1[0] * VSCALE, v1[1] * VSCALE, 0, false); q8.y = __builtin_amdgcn_cvt_pk_fp8_f32(v1[2] * VSCALE, v1[3] * VSCALE, q8.y, true);
                        *(u32x2*)((unsigned char*)V + (size_t)r * QW + c) = q8; }
                    else *(u32x4*)(AS + ((size_t)(c >> 4) * CHR + ch) * AK + j * 16 + (c & 15)) = w;
                }
            }
    }
};
__device__ __forceinline__ void p1_meta(Frame& F) {
    const int tid = threadIdx.x, o = tid >> 2, sub = tid & 3, row = o >> 3, n = F.vcu * 8 + (o & 7);
    if (F.vcu >= 256) return;
    const bf16* xp = WSP(bf16, WS_XN) + (size_t)row * DM + sub * 256; const bf16* wp = WSP(bf16, WS_WTIN) + (size_t)n * DM + sub * 256;
    float acc = 0.f;
#pragma unroll 4
    for (int k = 0; k < 256; k += 8) { const u32x4 a = *(const u32x4*)(xp + k), w = *(const u32x4*)(wp + k);
        acc += (bflo(a.x) * bflo(w.x) + bfhi(a.x) * bfhi(w.x)) + (bflo(a.y) * bflo(w.y) + bfhi(a.y) * bfhi(w.y)) + (bflo(a.z) * bflo(w.z) + bfhi(a.z) * bfhi(w.z)) + (bflo(a.w) * bflo(w.w) + bfhi(a.w) * bfhi(w.w)); }
    acc += __shfl_xor(acc, 1); acc += __shfl_xor(acc, 2);
    if (sub == 0) {
        if (n < 512) WSP(bf16, WS_Q)[(size_t)row * QW + n] = (bf16)f2bf(acc * C2);
        else if (n < 1024) WSP(bf16, WS_K)[(size_t)row * QW + n - 512] = (bf16)f2bf(acc);
        else if (n < 1536) (F.ws + WS_V)[(size_t)row * QW + n - 1024] = (unsigned char)(__builtin_amdgcn_cvt_pk_fp8_f32(acc * VSCALE, 0.f, 0, false) & 255);
        else { const int c = n - 1536; WSP(bf16, WS_ASSM)[((size_t)(c >> 4) * CHR + NCH) * AK + row * 16 + (c & 15)] = (bf16)f2bf(acc); }
    }
}
__device__ __forceinline__ void p1_inproj(Frame& F) {
    p1_meta(F);
    DenseSched S; S.ord.init(MT / 256, 8, F.G, (int)blockIdx.x); S.A = (const char*)WSP(bf16, WS_XN); S.Bt = (const char*)WSP(bf16, WS_WTIN); S.lda = DM; S.K = DM; S.rowoff = 256; S.ldab = DM * 2;
    EpiInProj E{WSP(bf16, WS_Q), WSP(bf16, WS_K), WSP(bf16, WS_V), WSP(bf16, WS_ASSM)};
    pg8::gemm_phase<EpiInProj, DenseSched, true>(F.lds, DM * 2, S, E);
}
struct EpiGlu {
    static constexpr bool PERM = true; static constexpr bool PREFETCH = false; const bf16* G; const float* bias; bf16* ATT;
    __device__ __forceinline__ void operator()(const f32x4 (&acc)[2][2][4][2], const GUnit& u, int wr, int wc, int fr, int fq) const {
        const int pm = u.i0, pn = u.i1;
#pragma unroll
        for (int bj = 0; bj < 2; ++bj) {
            const int c = pn * 256 + bj * 128 + wc * 32 + 8 * fq;
            const f32x4 b0 = *(const f32x4*)(bias + c), b1 = *(const f32x4*)(bias + c + 4);
#pragma unroll
            for (int ai = 0; ai < 2; ++ai)
#pragma unroll
                for (int m = 0; m < 4; ++m) {
                    const int r = pm * 256 + ai * 128 + wr * 64 + m * 16 + fr;
                    const u32x4 gv = __builtin_nontemporal_load((const u32x4*)(G + (size_t)r * SW + c));
                    const f32x4 v0 = acc[ai][bj][m][0] + b0, v1 = acc[ai][bj][m][1] + b1;
                    u32x4 w; w.x = pg8::cvt_pk_bf16(bflo(gv.x) * sigmoidf_(v0[0]), bfhi(gv.x) * sigmoidf_(v0[1])); w.y = pg8::cvt_pk_bf16(bflo(gv.y) * sigmoidf_(v0[2]), bfhi(gv.y) * sigmoidf_(v0[3]));
                    w.z = pg8::cvt_pk_bf16(bflo(gv.z) * sigmoidf_(v1[0]), bfhi(gv.z) * sigmoidf_(v1[1])); w.w = pg8::cvt_pk_bf16(bflo(gv.w) * sigmoidf_(v1[2]), bfhi(gv.w) * sigmoidf_(v1[3]));
                    *(u32x4*)(ATT + (size_t)r * DM + 512 + c) = w;
                }
        }
    }
};
__device__ __forceinline__ void p3_glu(Frame& F) {
    DenseSched S; S.ord.init(MT / 256, 2, F.G, (int)blockIdx.x); S.A = (const char*)F.out + DO_G; S.Bt = (const char*)WSP(bf16, WS_WTGLU); S.lda = SW; S.K = SW; S.rowoff = 0; S.ldab = SW * 2;
    EpiGlu E{(const bf16*)((const unsigned char*)F.out + DO_G), F.in[I_BGLU], WSP(bf16, WS_ATT)};
    pg8::gemm_phase<EpiGlu, DenseSched, true>(F.lds, SW * 2, S, E);
}
struct EpiOutProj {
    static constexpr bool PERM = true; static constexpr bool PREFETCH = false; const bf16* XN; bf16* Z;
    __device__ __forceinline__ void operator()(const f32x4 (&acc)[2][2][4][2], const GUnit& u, int wr, int wc, int fr, int fq) const {
        const int pm = u.i0, pn = u.i1;
#pragma unroll
        for (int ai = 0; ai < 2; ++ai)
#pragma unroll
            for (int m = 0; m < 4; ++m) {
                const int r = pm * 256 + ai * 128 + wr * 64 + m * 16 + fr;
#pragma unroll
                for (int bj = 0; bj < 2; ++bj) {
                    const int c = pn * 256 + bj * 128 + wc * 32 + 8 * fq;
                    const u32x4 hv = __builtin_nontemporal_load((const u32x4*)(XN + (size_t)(256 + r) * DM + c)); const f32x4 a0 = acc[ai][bj][m][0], a1 = acc[ai][bj][m][1];
                    u32x4 w; w.x = pg8::cvt_pk_bf16(ALPHA * bflo(hv.x) + a0[0], ALPHA * bfhi(hv.x) + a0[1]); w.y = pg8::cvt_pk_bf16(ALPHA * bflo(hv.y) + a0[2], ALPHA * bfhi(hv.y) + a0[3]);
                    w.z = pg8::cvt_pk_bf16(ALPHA * bflo(hv.z) + a1[0], ALPHA * bfhi(hv.z) + a1[1]); w.w = pg8::cvt_pk_bf16(ALPHA * bflo(hv.w) + a1[2], ALPHA * bfhi(hv.w) + a1[3]);
                    *(u32x4*)(Z + (size_t)r * DM + c) = w;
                }
            }
    }
};
__device__ __forceinline__ void p4_outproj(Frame& F) {
    DenseSched S; S.ord.init(MT / 256, 4, F.G, (int)blockIdx.x); S.A = (const char*)WSP(bf16, WS_ATT); S.Bt = (const char*)WSP(bf16, WS_WTOUT); S.lda = DM; S.K = DM; S.rowoff = 0; S.ldab = DM * 2;
    EpiOutProj E{WSP(bf16, WS_XN), WSP(bf16, WS_XN) + (size_t)256 * DM};
    pg8::gemm_phase<EpiOutProj, DenseSched, true>(F.lds, DM * 2, S, E);
}
constexpr int MOE_TAB_OFF = 131072, EPI_TAB_OFF = 131072 + 1024;
template <bool GATHER> struct MoeSched {
    static constexpr int lda = DM, ldab = DM;
    const LAS int* ust; const LAS int* gs; int ncol, G, c; const char* A; const char* Bt; size_t estride; const int* rowtok;
    __device__ __forceinline__ bool next(int i, GUnit& u) const {
        const int L = i * G + c; if (L >= ust[32]) return false;
        const int ln_ = (int)(threadIdx.x & 63u); const bool ge_ = (ln_ < 32) && (L >= ust[(ln_ & 31) + 1]);
        const int e = (int)__builtin_popcountll(__ballot(ge_));
        const int r = L - ust[e], rb = r / ncol, pn = r - rb * ncol;
        u.A = A; u.B = Bt + (size_t)e * estride + (size_t)pn * 256 * DM; u.i0 = e; u.i1 = pn; u.i4 = gs[e]; u.i2 = u.i4 + 256 * rb; u.i3 = gs[e + 1]; return true;
    }
    __device__ __forceinline__ int arow(const GUnit& u, int r) const { const int slot = u.i2 + r; return GATHER ? ((slot < u.i3) ? rowtok[(size_t)u.i0 * MT + (slot - u.i4)] : 0) : slot; }
    __device__ __forceinline__ int arow_next(const GUnit& u, int r, const LAS unsigned char* lds, int buf) const { return GATHER ? ((u.i2 + r < u.i3) ? ((const LAS int*)(lds + EPI_TAB_OFF + buf * 2048 + 1024))[r] : 0) : u.i2 + r; }
};
__device__ __forceinline__ void moe_tables(Frame& F, int ncol) {
    LAS int* ust = (LAS int*)(F.lds + MOE_TAB_OFF); LAS int* gs = ust + 64;
    __syncthreads();
    {   LAS int* gt = gs + 40;
        if (((int)threadIdx.x) < 32) gt[((int)threadIdx.x)] = ((const int*)(F.ws + WS_CTL))[CW_GTOT + GTOT_STRIDE * ((int)threadIdx.x)];
        __syncthreads();
        if (((int)threadIdx.x) < 32) { int run = 0;
#pragma unroll
            for (int i = 0; i < 31; ++i) run += (i < ((int)threadIdx.x)) ? gt[i] : 0;
            gs[((int)threadIdx.x)] = run; if (((int)threadIdx.x) == 31) gs[32] = run + gt[31]; } }
    __syncthreads();
    if (((int)threadIdx.x) < 32) { int run = 0;
#pragma unroll
        for (int i = 0; i < 31; ++i) run += (i < ((int)threadIdx.x)) ? ((gs[i + 1] - gs[i] + 255) >> 8) * ncol : 0;
        ust[((int)threadIdx.x)] = run;
        if (((int)threadIdx.x) == 31) ust[32] = run + ((gs[32] - gs[31] + 255) >> 8) * ncol; }
    __syncthreads();
}
struct EpiMoeUp {
    static constexpr bool PERM = true, PREFETCH = true; const float* bg; const float* bu; unsigned char* A2; const int* rowtok;
    __device__ __forceinline__ void prefetch(LAS unsigned char* lds, const GUnit& u, int buf, int wid, int lane) const {
        const long off = (wid < 4) ? ((long)((wid >> 1) & 1) * (long)(bu - bg) + u.i0 * DM + u.i1 * 128 + (wid & 1) * 64) : ((long)((const float*)rowtok - bg) + (long)u.i0 * MT + (u.i2 - u.i4) + (wid - 4) * 64);
        __builtin_amdgcn_global_load_lds((const unsigned*)(bg + off + lane), (LAS unsigned*)(lds + EPI_TAB_OFF + buf * 2048 + wid * 256), 4, 0, 0);
    }
    __device__ __forceinline__ void operator()(const f32x4 (&acc)[2][2][4][2], const GUnit& u, int wr, int wc, int fr, int fq, LAS unsigned char* lds, int buf) const {
        const int pn = u.i1, s0 = u.i2, send = u.i3, colo = pn * 128 + wc * 32 + 8 * fq;
        const LAS float* tb_ = (const LAS float*)(lds + EPI_TAB_OFF + buf * 2048) + wc * 32 + 8 * fq;
        constexpr float NC = -2.4554669595930157f, IC = 1.0f / NC;
        f32x2 bgc[4], buc[4];
        {   const f32x4 g0 = *(const LAS f32x4*)tb_, g1 = *(const LAS f32x4*)(tb_ + 4), u0 = *(const LAS f32x4*)(tb_ + 128), u1 = *(const LAS f32x4*)(tb_ + 132);
            bgc[0] = (f32x2){g0.x, g0.y} * NC; bgc[1] = (f32x2){g0.z, g0.w} * NC; bgc[2] = (f32x2){g1.x, g1.y} * NC; bgc[3] = (f32x2){g1.z, g1.w} * NC;
            buc[0] = ((f32x2){u0.x, u0.y} + 1.0f) * IC; buc[1] = ((f32x2){u0.z, u0.w} + 1.0f) * IC; buc[2] = ((f32x2){u1.x, u1.y} + 1.0f) * IC; buc[3] = ((f32x2){u1.z, u1.w} + 1.0f) * IC; }
#pragma unroll
        for (int ai = 0; ai < 2; ++ai)
#pragma unroll
            for (int m = 0; m < 4; ++m) {
                const int slot = s0 + ai * 128 + wr * 64 + m * 16 + fr;
                if (slot < send) {
                    f32x2 a[4];
#pragma unroll
                    for (int q = 0; q < 4; ++q) {
                        const f32x4 gv = acc[ai][0][m][q >> 1], uv = acc[ai][1][m][q >> 1];
                        const f32x2 g2 = (q & 1) ? (f32x2){gv.z, gv.w} : (f32x2){gv.x, gv.y}, u2 = (q & 1) ? (f32x2){uv.z, uv.w} : (f32x2){uv.x, uv.y};
                        const f32x2 x = g2 * NC + bgc[q], uu = u2 * IC + buc[q];
                        const f32x2 mm = {fmaxf(x.x, 7.0f * NC), fmaxf(x.y, 7.0f * NC)};
                        const f32x2 d = (f32x2){__builtin_amdgcn_exp2f(mm.x), __builtin_amdgcn_exp2f(mm.y)} + 1.0f;
                        const f32x2 r = {__builtin_amdgcn_rcpf(d.x), __builtin_amdgcn_rcpf(d.y)};
                        const f32x2 w2 = {__builtin_amdgcn_fmed3f(uu.x, 8.0f * IC, -6.0f * IC), __builtin_amdgcn_fmed3f(uu.y, 8.0f * IC, -6.0f * IC)};
                        a[q] = (mm * w2) * r; }
                    u32x2 w; w.x = __builtin_amdgcn_cvt_pk_fp8_f32(a[0].x, a[0].y, 0, false); w.x = __builtin_amdgcn_cvt_pk_fp8_f32(a[1].x, a[1].y, w.x, true);
                    w.y = __builtin_amdgcn_cvt_pk_fp8_f32(a[2].x, a[2].y, 0, false); w.y = __builtin_amdgcn_cvt_pk_fp8_f32(a[3].x, a[3].y, w.y, true);
                    *(u32x2*)(A2 + (size_t)slot * DM + colo) = w;
                }
            }
    }
};
__device__ __forceinline__ void p7_moe_up(Frame& F) {
    moe_tables(F, 8);
    MoeSched<true> S{(const LAS int*)(F.lds + MOE_TAB_OFF), (const LAS int*)(F.lds + MOE_TAB_OFF) + 64, 8, F.G, F.vcu, (const char*)(F.ws + WS_H1Q), (const char*)(F.ws + WS_X), (size_t)2048 * DM, WSP(int, WS_RT2)};
    EpiMoeUp E{F.in[I_BGATE], F.in[I_BUP], (unsigned char*)(F.ws + WS_A2), WSP(int, WS_RT2)};
    pg8::gemm_phase<EpiMoeUp, MoeSched<true>, true, true>(F.lds, DM, S, E);
}
constexpr float YSCALE = 16.0f;
struct EpiMoeDown {
    static constexpr bool PERM = true, PREFETCH = true; const float* bd; const int* slotdst; unsigned char* Y;
    __device__ __forceinline__ void prefetch(LAS unsigned char* lds, const GUnit& u, int buf, int wid, int lane) const {
        const long off = (wid < 4) ? ((long)u.i0 * MT + (u.i2 - u.i4) + wid * 64) : ((long)((const unsigned*)bd - (const unsigned*)slotdst) + u.i0 * DM + u.i1 * 256 + (wid - 4) * 64);
        const unsigned* src = (const unsigned*)slotdst + off + lane;
        __builtin_amdgcn_global_load_lds(src, (LAS unsigned*)(lds + EPI_TAB_OFF + buf * 2048 + wid * 256), 4, 0, 0);
    }
    __device__ __forceinline__ void operator()(const f32x4 (&acc)[2][2][4][2], const GUnit& u, int wr, int wc, int fr, int fq, LAS unsigned char* lds, int buf) const {
        const int pn = u.i1, s0 = u.i2, send = u.i3;
        const LAS int* tS = (const LAS int*)(lds + EPI_TAB_OFF + buf * 2048); const LAS float* tB = (const LAS float*)(lds + EPI_TAB_OFF + buf * 2048 + 1024);
        int dsts[2][4];
#pragma unroll
        for (int ai = 0; ai < 2; ++ai)
#pragma unroll
            for (int m = 0; m < 4; ++m) { const int slot = s0 + ai * 128 + wr * 64 + m * 16 + fr; dsts[ai][m] = (slot < send) ? tS[ai * 128 + wr * 64 + m * 16 + fr] : -1; }
        f32x4 bv[2][2];
#pragma unroll
        for (int bj = 0; bj < 2; ++bj) { const int c = bj * 128 + wc * 32 + 8 * fq; bv[bj][0] = *(const LAS f32x4*)(tB + c) * YSCALE; bv[bj][1] = *(const LAS f32x4*)(tB + c + 4) * YSCALE; }
#pragma unroll
        for (int ai = 0; ai < 2; ++ai)
#pragma unroll
            for (int m = 0; m < 4; ++m) {
                u32x2 w[2];
#pragma unroll
                for (int bj = 0; bj < 2; ++bj) {
                    const f32x4 v0 = acc[ai][bj][m][0] * YSCALE + bv[bj][0], v1 = acc[ai][bj][m][1] * YSCALE + bv[bj][1];
                    w[bj].x = __builtin_amdgcn_cvt_pk_fp8_f32(v0[0], v0[1], 0, false); w[bj].x = __builtin_amdgcn_cvt_pk_fp8_f32(v0[2], v0[3], w[bj].x, true);
                    w[bj].y = __builtin_amdgcn_cvt_pk_fp8_f32(v1[0], v1[1], 0, false); w[bj].y = __builtin_amdgcn_cvt_pk_fp8_f32(v1[2], v1[3], w[bj].y, true); }
                const auto rx = __builtin_amdgcn_permlane16_swap(w[0].x, w[1].x, false, false); const auto ry = __builtin_amdgcn_permlane16_swap(w[0].y, w[1].y, false, false);
                const int d = dsts[ai][m];
                if (d >= 0) {
                    const int c = pn * 256 + wc * 32 + ((fq & 1) ? 128 + 8 * (fq - 1) : 8 * fq);
                    u32x4 o; o.x = rx[0]; o.y = ry[0]; o.z = rx[1]; o.w = ry[1];
                    *(u32x4*)(Y + (size_t)d * DM + c) = o;
                }
            }
    }
};
__device__ __forceinline__ void p8_moe_down(Frame& F) {
    moe_tables(F, 4);
    MoeSched<false> S{(const LAS int*)(F.lds + MOE_TAB_OFF), (const LAS int*)(F.lds + MOE_TAB_OFF) + 64, 4, F.G, F.vcu, (const char*)(F.ws + WS_A2), (const char*)(F.ws + WS_WD), (size_t)DM * DM, nullptr};
    EpiMoeDown E{F.in[I_BDOWN], WSP(int, WS_SD2), (unsigned char*)F.out};
    pg8::gemm_phase<EpiMoeDown, MoeSched<false>, true, true>(F.lds, DM, S, E);
}


namespace attn {
typedef short bf16x8 __attribute__((ext_vector_type(8)));
typedef short s16x4 __attribute__((ext_vector_type(4)));
typedef short v4i16_t __attribute__((ext_vector_type(4)));
typedef float f32x16 __attribute__((ext_vector_type(16)));
constexpr int SLOTB = 16384, NKS = 3, NVS = 4;
constexpr int LDS_K = 0, LDS_V = NKS * SLOTB, LDS_WS = (NKS + NVS) * SLOTB, LDS_LUT = LDS_WS + 8 * 64 * 4, LDS_SG = LDS_LUT + 1024, LDS_END = LDS_SG + 512;
constexpr int XROW = 132;
__device__ __forceinline__ int crow(int r, int hi) { return (r & 3) + 8 * (r >> 2) + 4 * hi; }
__device__ __forceinline__ void glds16(const void* gsrc, unsigned lds_dst) { unsigned keep;
    asm volatile("s_mov_b32 %0, m0\n\ts_mov_b32 m0, %2\n\ts_nop 0\n\tglobal_load_lds_dwordx4 %1, off\n\ts_mov_b32 m0, %0" : "=&s"(keep) : "v"(gsrc), "s"(lds_dst) : "memory"); }
__device__ __forceinline__ float max3f(float a, float b, float c) { return __builtin_fmaxf(__builtin_fmaxf(a, b), c); }
typedef float f32x2_t __attribute__((ext_vector_type(2))); typedef __bf16 bf16x2_t __attribute__((ext_vector_type(2)));
__device__ __forceinline__ unsigned cvtpk_s(float lo, float hi) { f32x2_t v = {lo, hi}; bf16x2_t b = __builtin_convertvector(v, bf16x2_t); return __builtin_bit_cast(unsigned, b); }
#define AWAIT_BAR(N) asm volatile("s_waitcnt vmcnt(" #N ") lgkmcnt(0)\n\ts_barrier" ::: "memory")
__device__ __forceinline__ s16x4 vtr(const LAS unsigned char* p) { return __builtin_bit_cast(s16x4, __builtin_amdgcn_ds_read_tr16_b64_v4i16((LAS v4i16_t*)p)); }
__device__ __forceinline__ void qkt(f32x16& p0, f32x16& p1, const LAS unsigned char* Kslot, const bf16x8* qr, const f32x16& cinit, int r32, int hi) {
    const LAS unsigned char* kb = Kslot + hi * 1024 + r32 * 16;
    bf16x8 kf[8];
#pragma unroll
    for (int d0 = 0; d0 < 4; ++d0) { kf[2 * d0] = *(const LAS bf16x8*)(kb + d0 * 2048); kf[2 * d0 + 1] = *(const LAS bf16x8*)(kb + d0 * 2048 + 512); }
    __builtin_amdgcn_sched_barrier(0);
#pragma unroll
    for (int d0 = 0; d0 < 4; ++d0) {
        if (d0 == 0) { p0 = __builtin_amdgcn_mfma_f32_32x32x16_bf16(kf[0], qr[0], cinit, 0, 0, 0); p1 = __builtin_amdgcn_mfma_f32_32x32x16_bf16(kf[1], qr[0], cinit, 0, 0, 0); }
        else { p0 = __builtin_amdgcn_mfma_f32_32x32x16_bf16(kf[2 * d0], qr[d0], p0, 0, 0, 0); p1 = __builtin_amdgcn_mfma_f32_32x32x16_bf16(kf[2 * d0 + 1], qr[d0], p1, 0, 0, 0); }
    }
}
__device__ __forceinline__ float rowmax(const f32x16& p0, const f32x16& p1) {
    float a = max3f(p0[0], p0[1], p1[0]), b = max3f(p0[2], p0[3], p1[1]); a = max3f(a, p1[2], p1[3]);
#pragma unroll
    for (int r = 4; r < 16; r += 4) { a = max3f(a, p0[r], p0[r + 1]); b = max3f(b, p0[r + 2], p0[r + 3]); a = max3f(a, p1[r], p1[r + 1]); b = max3f(b, p1[r + 2], p1[r + 3]); }
    const float m = fmaxf(a, b);
    auto rr = __builtin_amdgcn_permlane32_swap(__float_as_uint(m), __float_as_uint(m), false, false);
    return fmaxf(__uint_as_float(rr[0]), __uint_as_float(rr[1]));
}
__device__ __forceinline__ void pv_ks(f32x16* o, const LAS unsigned char* vp, int ks, bf16x8 pa) {
#pragma unroll
    for (int d0 = 0; d0 < 4; ++d0) { const s16x4 lo = vtr(vp + d0 * 4096 + ks * 1024), hi = vtr(vp + d0 * 4096 + ks * 1024 + 512);
        o[d0] = __builtin_amdgcn_mfma_f32_32x32x16_bf16(pa, (bf16x8){lo[0], lo[1], lo[2], lo[3], hi[0], hi[1], hi[2], hi[3]}, o[d0], 0, 0, 0); }
}
struct WaveState { float mhat, l_reg; f32x16 o[4]; };
#define ASB() __builtin_amdgcn_sched_barrier(0)
template <int THR>
__device__ __forceinline__ bool scores(f32x16& p0, f32x16& p1, WaveState& W, int t, int qrow0, const LAS unsigned char* Kslot, const bf16x8* qr, float c15, const LAS float* LUT, LAS float* wsf, int r32, int hi) {
    const int kmax = (t == 0) ? -1 : (64 * (t - 1) + 63);
    const bool near = (t == 0) ? (qrow0 < 90) : (kmax - qrow0 > -91);
    f32x16 cin; { const float cv = (near ? 0.f : c15) - W.mhat;
#pragma unroll
        for (int r = 0; r < 16; ++r) cin[r] = cv; }
    qkt(p0, p1, Kslot, qr, cin, r32, hi);
    if (near) {
        const int relb0 = ((t == 0) ? -16 : 64 * (t - 1)) - qrow0 - r32 + 128;
#pragma unroll
        for (int r = 0; r < 16; ++r) { int i0 = relb0 + crow(r, hi); int i1 = i0 + 32; i0 = i0 < 0 ? 0 : i0; i1 = i1 < 0 ? 0 : i1; i1 = i1 > 191 ? 191 : i1; p0[r] += LUT[i0]; p1[r] += LUT[i1]; }
    }
    if (t == 0) {
#pragma unroll
        for (int r = 0; r < 16; ++r) { if (r >= 8) p0[r] = -INFINITY; p1[r] = -INFINITY; }
    }
    const float rm = rowmax(p0, p1);
    bool resc = false;
    if (t == 0 || __any(rm > 8.5f)) {
        const float dl = (t == 0) ? rm - 7.0f : fmaxf(rm - 7.0f, 0.f); W.mhat += dl;
#pragma unroll
        for (int r = 0; r < 16; ++r) { p0[r] -= dl; p1[r] -= dl; }
        const float f = __builtin_amdgcn_exp2f(-dl); W.l_reg *= f;
        if (t != 0) { if (hi == 0) wsf[r32] = f; resc = true; }
    }
    return resc;
}
__device__ __forceinline__ bf16x8 expack(const f32x16& p, int base, float& sacc) {
    float e[8];
#pragma unroll
    for (int j = 0; j < 8; ++j) { e[j] = __builtin_amdgcn_exp2f(p[base + j]); }
    sacc += ((e[0] + e[1]) + (e[2] + e[3])) + ((e[4] + e[5]) + (e[6] + e[7]));
    u32x4 w = (u32x4){cvtpk_s(e[0], e[1]), cvtpk_s(e[2], e[3]), cvtpk_s(e[4], e[5]), cvtpk_s(e[6], e[7])};
    return __builtin_bit_cast(bf16x8, w);
}
typedef int v8i_t __attribute__((ext_vector_type(8))); typedef int v2i_t __attribute__((ext_vector_type(2)));
__device__ __forceinline__ v8i_t vload8(const LAS unsigned char* vp, int d0) {
    const v2i_t r0 = __builtin_amdgcn_ds_read_tr8_b64_v2i32((LAS v2i_t*)(vp + d0 * 2048)), r1 = __builtin_amdgcn_ds_read_tr8_b64_v2i32((LAS v2i_t*)(vp + d0 * 2048 + 256));
    const v2i_t r2 = __builtin_amdgcn_ds_read_tr8_b64_v2i32((LAS v2i_t*)(vp + d0 * 2048 + 512)), r3 = __builtin_amdgcn_ds_read_tr8_b64_v2i32((LAS v2i_t*)(vp + d0 * 2048 + 768));
    return (v8i_t){r0.x, r0.y, r1.x, r1.y, r2.x, r2.y, r3.x, r3.y}; }
__device__ __forceinline__ void pvmm8(f32x16& o, const v8i_t& pa, const v8i_t& vb, int sc) {
    asm volatile("s_nop 1\n\tv_mfma_scale_f32_32x32x64_f8f6f4 %0, %1, %2, %0, %3, %3 op_sel_hi:[0,0,0]" : "+v"(o) : "v"(pa), "v"(vb), "v"(sc)); }
__device__ __forceinline__ void expack8(const f32x16& p, int base, float& sacc, int& w0, int& w1) {
    float e[8];
#pragma unroll
    for (int j = 0; j < 8; ++j) { float x = p[base + j]; asm volatile("" : "+v"(x)); e[j] = __builtin_amdgcn_exp2f(x); }
    sacc += ((e[0] + e[1]) + (e[2] + e[3])) + ((e[4] + e[5]) + (e[6] + e[7]));
    int a = __builtin_amdgcn_cvt_pk_fp8_f32(e[0], e[1], 0, false); a = __builtin_amdgcn_cvt_pk_fp8_f32(e[2], e[3], a, true);
    int c = __builtin_amdgcn_cvt_pk_fp8_f32(e[4], e[5], 0, false); c = __builtin_amdgcn_cvt_pk_fp8_f32(e[6], e[7], c, true);
    w0 = a; w1 = c; }
struct VF { s16x4 v[8]; };
__device__ __forceinline__ VF vload(const LAS unsigned char* vp, int ks) { VF f;
#pragma unroll
    for (int d0 = 0; d0 < 4; ++d0) { f.v[2 * d0] = vtr(vp + d0 * 4096 + ks * 1024); f.v[2 * d0 + 1] = vtr(vp + d0 * 4096 + ks * 1024 + 512); }
    return f; }
__device__ __forceinline__ void pvmm(f32x16* o, bf16x8 pa, const VF& f) {
#pragma unroll
    for (int d0 = 0; d0 < 4; ++d0) o[d0] = __builtin_amdgcn_mfma_f32_32x32x16_bf16(pa, (bf16x8){f.v[2 * d0][0], f.v[2 * d0][1], f.v[2 * d0][2], f.v[2 * d0][3], f.v[2 * d0 + 1][0], f.v[2 * d0 + 1][1], f.v[2 * d0 + 1][2], f.v[2 * d0 + 1][3]}, o[d0], 0, 0, 0);
}
template <int THR>
__device__ __forceinline__ void attn_unit(int b, int h, int qb, const bf16* Qg, const bf16* Kg, const unsigned char* Vg, bf16* ATT, float c15, float lam, LAS unsigned char* lds) {
    const int tid = threadIdx.x, lane = tid & 63, r32 = lane & 31, hi = lane >> 5; const int wid = __builtin_amdgcn_readfirstlane(tid >> 6), rg = wid & 3, m = wid >> 2;
    const unsigned lds0 = (unsigned)(uintptr_t)lds;
    LAS float* wsf = (LAS float*)(lds + LDS_WS) + wid * 64;
    LAS float* LUT = (LAS float*)(lds + LDS_LUT);
    const int qrow0 = qb * 128 + rg * 32;
    const int NT = 2 * qb + 3, tvis = 1 + 2 * qb + (rg >> 1);
    const size_t rowb = (size_t)256 + (size_t)b * SEQ;
    const bf16* ksrc = Kg + (size_t)lane * QW + h * 128 + wid * 8;
    const int vj = lane >> 1, vkey = ((vj & 3) + 8 * ((vj & 15) >> 2) + 4 * (wid & 1)) + 32 * (vj >> 4);
    const unsigned char* vsrc = Vg + (size_t)vkey * QW + h * 128 + 32 * (wid >> 1) + 16 * (lane & 1);
    const unsigned kdst = lds0 + LDS_K + wid * 1024, vdst = lds0 + LDS_V + wid * 1024;
#define ADMA(t, ks_, vs_) do { const size_t ro_ = ((t) == 0) ? (size_t)0 : (rowb + (size_t)64 * ((t) - 1)); const unsigned ko_ = (unsigned)(ks_) * SLOTB, vo_ = (unsigned)(vs_) * SLOTB; \
        glds16(ksrc + ro_ * QW, (unsigned)__builtin_amdgcn_readfirstlane(kdst + ko_)); glds16(ksrc + ro_ * QW + 64, (unsigned)__builtin_amdgcn_readfirstlane(kdst + ko_ + 8192)); \
        glds16(vsrc + ro_ * QW, (unsigned)__builtin_amdgcn_readfirstlane(vdst + vo_)); } while (0)
    ADMA(0, 0, 0); ADMA(1, 1, 1);
    bf16x8 qr[4];
    { const bf16* Qw = Qg + (rowb + qrow0 + r32) * QW + h * 128 + m * 64 + hi * 8;
#pragma unroll
      for (int d0 = 0; d0 < 4; ++d0) qr[d0] = *(const bf16x8*)(Qw + d0 * 16); }
    WaveState W; W.mhat = 0.f; W.l_reg = 0.f;
#pragma unroll
    for (int d0 = 0; d0 < 4; ++d0) W.o[d0] = f32x16{};
    const LAS unsigned char* vp0 = lds + LDS_V + hi * 1024 + ((lane & 15) >> 1) * 32 + ((lane >> 4) & 1) * 16 + (lane & 1) * 8;
    const LAS unsigned char* kp0 = lds + LDS_K + m * 8192;
    int kslot = 0, vslot = 0, pvslot = 0; bool pend = false;
    v8i_t pa = {}; const int sc1 = 127;
    {   AWAIT_BAR(3); ADMA(2, 2 % NKS, 2 % NVS);
        f32x16 p0, p1; (void)scores<THR>(p0, p1, W, 0, qrow0, kp0, qr, c15, LUT, wsf, r32, hi);
        float sacc = 0.f; int pw[8];
        expack8(p0, 0, sacc, pw[0], pw[1]); expack8(p0, 8, sacc, pw[2], pw[3]); expack8(p1, 0, sacc, pw[4], pw[5]); expack8(p1, 8, sacc, pw[6], pw[7]);
        pa = (v8i_t){pw[0], pw[1], pw[2], pw[3], pw[4], pw[5], pw[6], pw[7]};
        W.l_reg += sacc; pend = true; pvslot = 0; kslot = 1; vslot = 1; }
    for (int t = 1; t < NT; ++t) {
        __builtin_assume(t > 0);
        if (t + 1 < NT) { AWAIT_BAR(3); } else { AWAIT_BAR(0); }
        if (t + 2 < NT) { ADMA(t + 2, (kslot + 2) % NKS, (vslot + 2) % NVS); }
        const bool vis = t <= tvis; const LAS unsigned char* vp = vp0 + pvslot * SLOTB;
        if (vis) {
            f32x16 p0, p1;
            const bool resc = scores<THR>(p0, p1, W, t, qrow0, kp0 + kslot * SLOTB, qr, c15, LUT, wsf, r32, hi);
            float sacc = 0.f;
            int pw[8];
            {   const v8i_t b0 = vload8(vp, 0), b1 = vload8(vp, 1); ASB();
                pvmm8(W.o[0], pa, b0, sc1); expack8(p0, 0, sacc, pw[0], pw[1]); const v8i_t b2 = vload8(vp, 2); ASB();
                pvmm8(W.o[1], pa, b1, sc1); expack8(p0, 8, sacc, pw[2], pw[3]); const v8i_t b3 = vload8(vp, 3); ASB();
                pvmm8(W.o[2], pa, b2, sc1); expack8(p1, 0, sacc, pw[4], pw[5]); ASB();
                pvmm8(W.o[3], pa, b3, sc1); expack8(p1, 8, sacc, pw[6], pw[7]); ASB(); }
            pa = (v8i_t){pw[0], pw[1], pw[2], pw[3], pw[4], pw[5], pw[6], pw[7]};
            if (resc) {
                asm volatile("s_waitcnt lgkmcnt(0)\n\ts_nop 15\n\ts_nop 15\n\ts_nop 7" ::: "memory");
#pragma unroll
                for (int r = 0; r < 16; ++r) { const float fr = wsf[crow(r, hi)];
#pragma unroll
                    for (int d0 = 0; d0 < 4; ++d0) { float x = W.o[d0][r]; asm volatile("v_mul_f32 %0, %0, %1" : "+v"(x) : "v"(fr)); W.o[d0][r] = x; } }
                asm volatile("s_waitcnt lgkmcnt(0)" ::: "memory");
            }
            W.l_reg += sacc; pend = true; pvslot = vslot;
        } else if (pend) {
            const v8i_t b0 = vload8(vp, 0), b1 = vload8(vp, 1); ASB();
            pvmm8(W.o[0], pa, b0, sc1); const v8i_t b2 = vload8(vp, 2); ASB();
            pvmm8(W.o[1], pa, b1, sc1); const v8i_t b3 = vload8(vp, 3); ASB();
            pvmm8(W.o[2], pa, b2, sc1); pvmm8(W.o[3], pa, b3, sc1);
            asm volatile("s_nop 15\n\ts_nop 15" ::: "memory"); ASB();
            pend = false;
        }
        kslot = (kslot == NKS - 1) ? 0 : kslot + 1; vslot = (vslot == NVS - 1) ? 0 : vslot + 1;
    }
    if (pend) { const LAS unsigned char* vp = vp0 + pvslot * SLOTB;
        const v8i_t b0 = vload8(vp, 0), b1 = vload8(vp, 1); ASB();
        pvmm8(W.o[0], pa, b0, sc1); const v8i_t b2 = vload8(vp, 2); ASB();
        pvmm8(W.o[1], pa, b1, sc1); const v8i_t b3 = vload8(vp, 3); ASB();
        pvmm8(W.o[2], pa, b2, sc1); pvmm8(W.o[3], pa, b3, sc1); }
    asm volatile("s_nop 15\n\ts_nop 15\n\ts_nop 7" ::: "memory"); ASB();
    float l_reg = W.l_reg;
    { auto rr = __builtin_amdgcn_permlane32_swap(__float_as_uint(l_reg), __float_as_uint(l_reg), false, false); l_reg = __uint_as_float(rr[0]) + __uint_as_float(rr[1]); }
    if (hi == 0) wsf[32 + r32] = l_reg;
    asm volatile("s_waitcnt lgkmcnt(0)" ::: "memory");
    float rli[16];
#pragma unroll
    for (int r = 0; r < 16; ++r) rli[r] = __builtin_amdgcn_rcpf(wsf[32 + crow(r, hi)]) * (1.0f / VSCALE);
    AWAIT_BAR(0);
    LAS float* X = (LAS float*)lds + rg * (32 * XROW);
    if (m == 1) {
#pragma unroll
        for (int r = 0; r < 16; ++r) { const float sc = rli[r] * lam;
#pragma unroll
            for (int d0 = 0; d0 < 4; ++d0) X[crow(r, hi) * XROW + 32 * d0 + r32] = W.o[d0][r] * sc; }
    }
    AWAIT_BAR(0);
    if (m == 0) {
#pragma unroll
        for (int r = 0; r < 16; ++r) {
#pragma unroll
            for (int d0 = 0; d0 < 4; ++d0) { LAS float* xp = X + crow(r, hi) * XROW + 32 * d0 + r32; *xp = W.o[d0][r] * rli[r] - *xp; } }
        asm volatile("s_waitcnt lgkmcnt(0)" ::: "memory");
        const int row = lane >> 1, half = lane & 1; const LAS float* xr = X + row * XROW + half * 64;
        f32x4 v[16]; float ss = 0.f;
#pragma unroll
        for (int i = 0; i < 16; ++i) { v[i] = *(const LAS f32x4*)(xr + 4 * i); ss += (v[i].x * v[i].x + v[i].y * v[i].y) + (v[i].z * v[i].z + v[i].w * v[i].w); }
        ss += __shfl_xor(ss, 1);
        const float rn = rsqrtf(ss * (1.0f / 128.0f) + LN_EPS) * 0.8f;
        bf16* dst = ATT + (size_t)(b * SEQ + qb * 128 + rg * 32 + row) * DM + h * 128 + half * 64;
#pragma unroll
        for (int i = 0; i < 8; ++i) { const LAS float* sg_ = (const LAS float*)(lds + LDS_SG) + half * 64 + 8 * i; const f32x4 g0 = *(const LAS f32x4*)sg_, g1 = *(const LAS f32x4*)(sg_ + 4); const f32x4 a = v[2 * i] * rn * g0, c = v[2 * i + 1] * rn * g1;
            u32x4 w; w.x = cvtpk_s(a.x, a.y); w.y = cvtpk_s(a.z, a.w); w.z = cvtpk_s(c.x, c.y); w.w = cvtpk_s(c.z, c.w); *(u32x4*)(dst + 8 * i) = w; }
    }
    AWAIT_BAR(0);
#undef ADMA
}
}
__device__ __forceinline__ void p6_attention_mfma(Frame& F) {
    const float lam = WSP(float, WS_PAR)[PF_LAM];
    const int bh = F.vcu >> 5, sidx = F.vcu & 31;
    const float c15 = F.in[I_RELB][15 * NH + (bh & 3)] * LOG2E;
    {   LAS float* LUT = (LAS float*)(F.lds + attn::LDS_LUT); const int tq = (int)threadIdx.x;
        __syncthreads();
        if (tq < 192) LUT[tq] = F.in[I_RELB][t5_bucket(tq - 128) * NH + (bh & 3)] * LOG2E;
        else if (tq < 320) ((LAS float*)(F.lds + attn::LDS_SG))[tq - 192] = F.in[I_SUBLN][tq - 192];
        __syncthreads(); }
    for (int i = 0; i < 4; ++i) {
        const int qb = (i == 0) ? 127 - sidx : (i == 1) ? 64 + sidx : (i == 2) ? 63 - sidx : sidx;
        attn::attn_unit<8>(bh >> 2, bh & 3, qb, WSP(bf16, WS_Q), WSP(bf16, WS_K), (const unsigned char*)(F.ws + WS_V), WSP(bf16, WS_ATT), c15, lam, F.lds);
    }
}

__device__ __forceinline__ void reduce_scatter32(float (&p)[32], int lane) {
#pragma unroll
    for (int i = 0; i < 16; ++i) { auto r = __builtin_amdgcn_permlane32_swap(__float_as_uint(p[i]), __float_as_uint(p[i + 16]), false, false); p[i] = __uint_as_float(r[0]) + __uint_as_float(r[1]); }
#pragma unroll
    for (int i = 0; i < 8; ++i) { auto r = __builtin_amdgcn_permlane16_swap(__float_as_uint(p[i]), __float_as_uint(p[i + 8]), false, false); p[i] = __uint_as_float(r[0]) + __uint_as_float(r[1]); }
    { const bool up = (lane & 8) != 0;
#pragma unroll
      for (int i = 0; i < 4; ++i) { const float keep = up ? p[i + 4] : p[i], send = up ? p[i] : p[i + 4]; p[i] = keep + dpp_f<DPP_ROR8>(send); } }
    { const bool up = (lane & 4) != 0;
#pragma unroll
      for (int i = 0; i < 2; ++i) { const float keep = up ? p[i + 2] : p[i], send = up ? p[i] : p[i + 2]; p[i] = keep + dpp_f<DPP_HMIRROR>(send); } }
    { const bool up = (lane & 2) != 0; const float keep = up ? p[1] : p[0], send = up ? p[0] : p[1]; p[0] = keep + dpp_f<DPP_XOR2>(send); }
}
struct SsmSched {
    static constexpr int lda = AK, ldab = AK * 2;
    int G, c, K; const char* AS; const char* Bt;
    __device__ __forceinline__ bool next(int i, GUnit& u) const { const int L = i * G + c; if (L >= 256) return false; const int g = L >> 3, pm = L & 7;
        u.A = AS + (size_t)g * CHR * AK * 2; u.B = Bt + (size_t)g * 256 * K * 2; u.i0 = g; u.i1 = pm; u.i2 = 0; u.i3 = 0; u.i4 = 0; return true; }
    __device__ __forceinline__ int arow(const GUnit& u, int r) const { return u.i1 * 256 + r; }
    __device__ __forceinline__ int arow_next(const GUnit& u, int r, const LAS unsigned char*, int) const { return arow(u, r); }
};
struct EpiSsmE {
    static constexpr bool PERM = false; static constexpr bool PREFETCH = false; float* E;
    __device__ __forceinline__ void operator()(const f32x4 (&acc)[2][2][4][2], const GUnit& u, int wr, int wc, int fr, int fq) const {
        const int g = u.i0, pm = u.i1;
#pragma unroll
        for (int ai = 0; ai < 2; ++ai)
#pragma unroll
            for (int m = 0; m < 4; ++m) { const int ch = pm * 256 + ai * 128 + wr * 64 + m * 16 + fr;
#pragma unroll
                for (int n = 0; n < 2; ++n) *(f32x4*)(E + ((size_t)g * NCH + ch) * 128 + wc * 32 + 16 * n + 4 * fq) = acc[ai][0][m][n]; }
    }
};
__device__ __forceinline__ float ld_sc1(const float* p) { return __uint_as_float(__hip_atomic_load((const unsigned*)p, __ATOMIC_RELAXED, __HIP_MEMORY_SCOPE_AGENT)); }
__device__ __forceinline__ void ps1_ssm_e(Frame& F) {
    SsmSched S{F.G, F.vcu, 256, (const char*)WSP(bf16, WS_ASSM), (const char*)WSP(bf16, WS_BTE)};
    float* E = (float*)((unsigned char*)F.out + DO_E); float* BE = (float*)((unsigned char*)F.out + DO_BE); float* PAR = WSP(float, WS_PAR);
    EpiSsmE Ep{E};
    pg8::gemm_phase<EpiSsmE, SsmSched, true>(F.lds, 256 * 2, S, Ep);
    if (F.vcu >= 256) return;
    asm volatile("s_waitcnt vmcnt(0)" ::: "memory"); __syncthreads();
    const int g = F.vcu >> 3, pm = F.vcu & 7, n = ((int)threadIdx.x) & 63, q = ((int)threadIdx.x) >> 6;
    const float a16r = PAR[PF_A16 + (g * 64 + n) * 2], a16i = PAR[PF_A16 + (g * 64 + n) * 2 + 1];
#pragma unroll
    for (int bq = 0; bq < 2; ++bq) {
        const int bl = q + 8 * bq; const float* ep = E + ((size_t)g * NCH + pm * 256 + bl * 16) * 128 + n;
        float er[16], ei[16];
#pragma unroll
        for (int i = 0; i < 16; ++i) { er[i] = ld_sc1(ep + i * 128); ei[i] = ld_sc1(ep + i * 128 + 64); }
        float sr = 0.f, si = 0.f;
#pragma unroll
        for (int i = 0; i < 16; ++i) { const float nr = a16r * sr - a16i * si + er[i], ni = a16r * si + a16i * sr + ei[i]; sr = nr; si = ni; }
        BE[((size_t)g * 128 + pm * 16 + bl) * 128 + n] = sr; BE[((size_t)g * 128 + pm * 16 + bl) * 128 + 64 + n] = si;
    }
    if (pm == 0 && ((int)threadIdx.x) < 128) {
        const bf16* up = WSP(bf16, WS_ASSM) + ((size_t)g * CHR + NCH) * AK; const bf16* wp = WSP(bf16, WS_BTE) + ((size_t)g * 256 + ((int)threadIdx.x)) * 256; float acc = 0.f;
        for (int k = 0; k < 256; k += 8) { const u32x4 a = *(const u32x4*)(up + k), w = *(const u32x4*)(wp + k);
            acc += bflo(a.x) * bflo(w.x) + bfhi(a.x) * bfhi(w.x) + bflo(a.y) * bflo(w.y) + bfhi(a.y) * bfhi(w.y) + bflo(a.z) * bflo(w.z) + bfhi(a.z) * bfhi(w.z) + bflo(a.w) * bflo(w.w) + bfhi(a.w) * bfhi(w.w); }
        PAR[PF_SM + (g * 64 + (((int)threadIdx.x) & 63)) * 2 + (((int)threadIdx.x) >> 6)] = acc;
    }
}
__device__ __forceinline__ void ps2_ssm_carry(Frame& F) {
    const int gw = F.vcu * 8 + F.wave; if (gw >= 2048) return;
    const int b = gw >> 10, g = (gw >> 5) & 31, s = gw & 31, n = ((int)(threadIdx.x & 63u)), gn = g * 64 + n;
    const float* PAR = WSP(float, WS_PAR); const float* E = (const float*)((const unsigned char*)F.out + DO_E); const float* BE = (const float*)((const unsigned char*)F.out + DO_BE);
    bf16* AS = WSP(bf16, WS_ASSM) + (size_t)g * CHR * AK;
    const float a16r = PAR[PF_A16 + gn * 2], a16i = PAR[PF_A16 + gn * 2 + 1], a256r = PAR[PF_A256 + gn * 2], a256i = PAR[PF_A256 + gn * 2 + 1];
    float cr = PAR[PF_SM + gn * 2], ci = PAR[PF_SM + gn * 2 + 1];
    const float* bep = BE + ((size_t)g * 128 + b * 64) * 128 + n;
    int bb = 0;
#pragma unroll
    for (int pass = 0; pass < 2; ++pass) {
        const int blk = pass == 0 ? s : 63 - s;
#pragma unroll 4
        for (; bb < blk; ++bb) { const float er = bep[bb * 128], ei = bep[bb * 128 + 64]; const float nr = a256r * cr - a256i * ci + er, ni = a256r * ci + a256i * cr + ei; cr = nr; ci = ni; }
        const int ch0 = b * 1024 + blk * 16; const float* ep = E + ((size_t)g * NCH + ch0) * 128 + n;
        float er[16], ei[16];
#pragma unroll
        for (int i = 0; i < 16; ++i) { er[i] = ep[i * 128]; ei[i] = ep[i * 128 + 64]; }
        float sr = cr, si = ci;
#pragma unroll
        for (int i = 0; i < 16; ++i) {
            bf16* dst = AS + (size_t)(ch0 + i) * AK + 256 + n; dst[0] = (bf16)f2bf(sr); dst[64] = (bf16)f2bf(si);
            const float nr = a16r * sr - a16i * si + er[i], ni = a16r * si + a16i * sr + ei[i]; sr = nr; si = ni; }
    }
}
struct EpiSsmY {
    static constexpr bool PERM = true; static constexpr bool PREFETCH = false; bf16* Gb;
    __device__ __forceinline__ void operator()(const f32x4 (&acc)[2][2][4][2], const GUnit& u, int wr, int wc, int fr, int fq) const {
        const int g = u.i0, pm = u.i1;
#pragma unroll
        for (int ai = 0; ai < 2; ++ai)
#pragma unroll
            for (int m = 0; m < 4; ++m) { const int ch = pm * 256 + ai * 128 + wr * 64 + m * 16 + fr;
#pragma unroll
                for (int bj = 0; bj < 2; ++bj) { const int c = bj * 128 + wc * 32 + 8 * fq, i = c >> 4, cc = c & 15;
                    const f32x4 v0 = acc[ai][bj][m][0], v1 = acc[ai][bj][m][1];
                    u32x4 w; w.x = pg8::cvt_pk_bf16(gelu_tanh(v0[0]), gelu_tanh(v0[1])); w.y = pg8::cvt_pk_bf16(gelu_tanh(v0[2]), gelu_tanh(v0[3])); w.z = pg8::cvt_pk_bf16(gelu_tanh(v1[0]), gelu_tanh(v1[1])); w.w = pg8::cvt_pk_bf16(gelu_tanh(v1[2]), gelu_tanh(v1[3]));
                    *(u32x4*)(Gb + (size_t)(ch * 16 + i) * SW + g * 16 + cc) = w; } }
    }
};
__device__ __forceinline__ void ssm_carry_local(Frame& F) {
    if (F.vcu >= 256) return;
    const int g = F.vcu >> 3, pm = F.vcu & 7, b = pm >> 2, n = ((int)(threadIdx.x & 63u)), gn = g * 64 + n;
    const float* PAR = WSP(float, WS_PAR); const float* E = (const float*)((const unsigned char*)F.out + DO_E); const float* BE = (const float*)((const unsigned char*)F.out + DO_BE);
    bf16* AS = WSP(bf16, WS_ASSM) + (size_t)g * CHR * AK;
    const float a16r = PAR[PF_A16 + gn * 2], a16i = PAR[PF_A16 + gn * 2 + 1], a256r = PAR[PF_A256 + gn * 2], a256i = PAR[PF_A256 + gn * 2 + 1];
    float cr = PAR[PF_SM + gn * 2], ci = PAR[PF_SM + gn * 2 + 1];
    const float* bep = BE + ((size_t)g * 128 + b * 64) * 128 + n;
    const int blk0 = (pm & 3) * 16 + 2 * F.wave;
#pragma unroll 16
    for (int bb = 0; bb < blk0; ++bb) { const float er = bep[bb * 128], ei = bep[bb * 128 + 64]; const float nr = a256r * cr - a256i * ci + er, ni = a256r * ci + a256i * cr + ei; cr = nr; ci = ni; }
#pragma unroll
    for (int q = 0; q < 2; ++q) {
        const int ch0 = b * 1024 + (blk0 + q) * 16; const float* ep = E + ((size_t)g * NCH + ch0) * 128 + n;
        float er[16], ei[16];
#pragma unroll
        for (int i = 0; i < 16; ++i) { er[i] = ep[i * 128]; ei[i] = ep[i * 128 + 64]; }
#pragma unroll
        for (int i = 0; i < 16; ++i) {
            bf16* dst = AS + (size_t)(ch0 + i) * AK + 256 + n; dst[0] = (bf16)f2bf(cr); dst[64] = (bf16)f2bf(ci);
            const float nr = a16r * cr - a16i * ci + er[i], ni = a16r * ci + a16i * cr + ei[i]; cr = nr; ci = ni; }
    }
    asm volatile("s_waitcnt vmcnt(0)" ::: "memory");
    __syncthreads();
}
__device__ __forceinline__ void ps3_ssm_y(Frame& F) {
    ssm_carry_local(F);
    SsmSched S{F.G, F.vcu, AK, (const char*)WSP(bf16, WS_ASSM), (const char*)WSP(bf16, WS_BTY)};
    EpiSsmY Ep{(bf16*)((unsigned char*)F.out + DO_G)};
    pg8::gemm_phase<EpiSsmY, SsmSched, true>(F.lds, AK * 2, S, Ep);
}

__device__ __forceinline__ void p5_ln1_router(Frame& F) {
    LAS float* wT = (LAS float*)F.lds;
    LAS float* lg = wT + 32 * 1024;
    LAS int* hist = (LAS int*)(lg + 8 * 2 * 32);
    LAS int* sbase = hist + 32; LAS int* scur = sbase + 32; LAS int* tel = scur + 32;
    const bf16* Z = WSP(bf16, WS_XN) + (size_t)256 * DM; f32x2* STAT = (f32x2*)(F.ws + WS_STAT); int* tok_e = WSP(int, WS_TOKE); float* tok_g = WSP(float, WS_TOKG);
    __syncthreads();
    for (int k = ((int)threadIdx.x); k < DM; k += 512) {
        const f32x4* src = (const f32x4*)(F.in[I_WROUTER] + (size_t)k * NE);
#pragma unroll
        for (int q = 0; q < 8; ++q) { const f32x4 v = src[q]; wT[(4 * q + 0) * 1024 + k] = v.x; wT[(4 * q + 1) * 1024 + k] = v.y; wT[(4 * q + 2) * 1024 + k] = v.z; wT[(4 * q + 3) * 1024 + k] = v.w; }
    }
    if (((int)threadIdx.x) < 32) hist[((int)threadIdx.x)] = 0;
    __syncthreads();
    const int lane = ((int)(threadIdx.x & 63u));
    for (int pr = 0; pr < 8; ++pr) {
        const int t0 = F.vcu * 128 + F.wave * 16 + pr * 2;
        f32x4 h0[4], h1[4];
        {
            const u32x2* z0 = (const u32x2*)(Z + (size_t)t0 * DM) + lane; const u32x2* z1 = z0 + DM / 4;
            float s0 = 0.f, s1 = 0.f;
#pragma unroll
            for (int j = 0; j < 4; ++j) { const u32x2 a = __builtin_nontemporal_load(z0 + 64 * j), c = __builtin_nontemporal_load(z1 + 64 * j); h0[j] = (f32x4){bflo(a.x), bfhi(a.x), bflo(a.y), bfhi(a.y)}; h1[j] = (f32x4){bflo(c.x), bfhi(c.x), bflo(c.y), bfhi(c.y)};
                s0 += (h0[j].x + h0[j].y) + (h0[j].z + h0[j].w); s1 += (h1[j].x + h1[j].y) + (h1[j].z + h1[j].w); }
            const float m0 = wave_sum(s0) * (1.f / DM), m1 = wave_sum(s1) * (1.f / DM); float q0 = 0.f, q1 = 0.f;
#pragma unroll
            for (int j = 0; j < 4; ++j) { h0[j] = h0[j] - m0; h1[j] = h1[j] - m1; q0 += (h0[j].x * h0[j].x + h0[j].y * h0[j].y) + (h0[j].z * h0[j].z + h0[j].w * h0[j].w);
                q1 += (h1[j].x * h1[j].x + h1[j].y * h1[j].y) + (h1[j].z * h1[j].z + h1[j].w * h1[j].w); }
            const float r0 = rsqrtf(wave_sum(q0) * (1.f / DM) + LN_EPS), r1 = rsqrtf(wave_sum(q1) * (1.f / DM) + LN_EPS);
            if (lane == 0) { STAT[t0] = (f32x2){m0, r0}; STAT[t0 + 1] = (f32x2){m1, r1}; }
            unsigned* q8a = (unsigned*)(F.ws + WS_H1Q + (size_t)t0 * DM) + lane; unsigned* q8b = q8a + DM / 4;
#pragma unroll
            for (int j = 0; j < 4; ++j) { const f32x4 gg = ((const f32x4*)F.in[I_LN1G])[lane + 64 * j], bb = ((const f32x4*)F.in[I_LN1B])[lane + 64 * j];
                h0[j] = h0[j] * r0 * gg + bb; h1[j] = h1[j] * r1 * gg + bb;
                unsigned qa = __builtin_amdgcn_cvt_pk_fp8_f32(h0[j].x, h0[j].y, 0, false); qa = __builtin_amdgcn_cvt_pk_fp8_f32(h0[j].z, h0[j].w, qa, true); q8a[64 * j] = qa;
                unsigned qb = __builtin_amdgcn_cvt_pk_fp8_f32(h1[j].x, h1[j].y, 0, false); qb = __builtin_amdgcn_cvt_pk_fp8_f32(h1[j].z, h1[j].w, qb, true); q8b[64 * j] = qb; }
        }
        float p0[32], p1[32];
        {   f32x2 hp[16];
#pragma unroll
            for (int j = 0; j < 4; ++j) { hp[4 * j] = (f32x2){h0[j].x, h1[j].x}; hp[4 * j + 1] = (f32x2){h0[j].y, h1[j].y}; hp[4 * j + 2] = (f32x2){h0[j].z, h1[j].z}; hp[4 * j + 3] = (f32x2){h0[j].w, h1[j].w}; }
#pragma unroll
            for (int eg = 0; eg < 8; ++eg) {
                f32x4 w[4][4];
#pragma unroll
                for (int q = 0; q < 4; ++q)
#pragma unroll
                    for (int j = 0; j < 4; ++j) w[q][j] = *(const LAS f32x4*)(wT + (4 * eg + q) * 1024 + 256 * j + 4 * lane);
                __builtin_amdgcn_sched_barrier(0);
                f32x2 a[4];
#pragma unroll
                for (int q = 0; q < 4; ++q) a[q] = (f32x2){0.f, 0.f};
#pragma unroll
                for (int j = 0; j < 4; ++j) {
#pragma unroll
                    for (int q = 0; q < 4; ++q) a[q] = hp[4 * j] * (f32x2){w[q][j].x, w[q][j].x} + a[q];
#pragma unroll
                    for (int q = 0; q < 4; ++q) a[q] = hp[4 * j + 1] * (f32x2){w[q][j].y, w[q][j].y} + a[q];
#pragma unroll
                    for (int q = 0; q < 4; ++q) a[q] = hp[4 * j + 2] * (f32x2){w[q][j].z, w[q][j].z} + a[q];
#pragma unroll
                    for (int q = 0; q < 4; ++q) a[q] = hp[4 * j + 3] * (f32x2){w[q][j].w, w[q][j].w} + a[q]; }
#pragma unroll
                for (int q = 0; q < 4; ++q) { p0[4 * eg + q] = a[q].x; p1[4 * eg + q] = a[q].y; }
            }
        }
        reduce_scatter32(p0, lane); reduce_scatter32(p1, lane);
        const float l0 = p0[0] + dpp_f<DPP_XOR1>(p0[0]), l1 = p1[0] + dpp_f<DPP_XOR1>(p1[0]);
        const int e_me = lane >> 1; const float br = F.in[I_BROUTER][e_me];
        float v = ((lane & 1) ? l1 : l0) + br; float tv[4]; int te[4];
#pragma unroll
        for (int k = 0; k < 4; ++k) {
            float bv = v; int be = e_me;
            { float ov = dpp_f<DPP_XOR2>(bv); int oe = dpp_i<DPP_XOR2>(be); bool take = (ov > bv) || (ov == bv && oe < be); bv = take ? ov : bv; be = take ? oe : be;
              ov = dpp_f<DPP_ROR4>(bv); oe = dpp_i<DPP_ROR4>(be); take = (ov > bv) || (ov == bv && oe < be); bv = take ? ov : bv; be = take ? oe : be;
              ov = dpp_f<DPP_ROR8>(bv); oe = dpp_i<DPP_ROR8>(be); take = (ov > bv) || (ov == bv && oe < be); bv = take ? ov : bv; be = take ? oe : be;
              { auto rv = __builtin_amdgcn_permlane16_swap(__float_as_uint(bv), __float_as_uint(bv), false, false); auto re = __builtin_amdgcn_permlane16_swap((unsigned)be, (unsigned)be, false, false);
                const float v0 = __uint_as_float(rv[0]), v1 = __uint_as_float(rv[1]); const int e0 = (int)re[0], e1 = (int)re[1]; take = (v1 > v0) || (v1 == v0 && e1 < e0); bv = take ? v1 : v0; be = take ? e1 : e0; }
              { auto rv = __builtin_amdgcn_permlane32_swap(__float_as_uint(bv), __float_as_uint(bv), false, false); auto re = __builtin_amdgcn_permlane32_swap((unsigned)be, (unsigned)be, false, false);
                const float v0 = __uint_as_float(rv[0]), v1 = __uint_as_float(rv[1]); const int e0 = (int)re[0], e1 = (int)re[1]; take = (v1 > v0) || (v1 == v0 && e1 < e0); bv = take ? v1 : v0; be = take ? e1 : e0; } }
            tv[k] = bv; te[k] = be; if (e_me == be) v = -3.0e38f;
        }
        if (lane < 2) {
            const int t = t0 + lane;
            const float e1 = __expf(tv[1] - tv[0]), e2 = __expf(tv[2] - tv[0]), e3 = __expf(tv[3] - tv[0]); const float inv = 1.0f / (1.0f + e1 + e2 + e3);
            *(int4*)(tok_e + t * 4) = make_int4(te[0], te[1], te[2], te[3]);
            { LAS int* tl = tel + (t - F.vcu * 128) * 4; tl[0] = te[0]; tl[1] = te[1]; tl[2] = te[2]; tl[3] = te[3]; }
            *(f32x4*)(tok_g + t * 4) = (f32x4){inv, e1 * inv, e2 * inv, e3 * inv};
#pragma unroll
            for (int k = 0; k < 4; ++k) atomicAdd((int*)(hist + te[k]), 1);
        }
    }
    __syncthreads();
    if (((int)threadIdx.x) < 32) { sbase[((int)threadIdx.x)] = (int)atomicAdd((unsigned*)(F.ws + WS_CTL) + CW_GTOT + GTOT_STRIDE * ((int)threadIdx.x), (unsigned)hist[((int)threadIdx.x)]); scur[((int)threadIdx.x)] = 0; }
    __syncthreads();
    {   const int pl = (int)threadIdx.x, pair = F.vcu * 512 + pl;
        const int e = tel[pl];
        const int pos = sbase[e] + atomicAdd((int*)(scur + e), 1);
        WSP(int, WS_RT2)[(size_t)e * MT + pos] = pair >> 2; WSP(int, WS_SD2)[(size_t)e * MT + pos] = pair; }
}

__device__ __forceinline__ void p6_dispatch(Frame&) { }

__device__ __forceinline__ void p9_final(Frame& F) {
    const bf16* H1 = WSP(bf16, WS_XN) + (size_t)256 * DM; const f32x2* STAT = (const f32x2*)(F.ws + WS_STAT); const int lane = ((int)(threadIdx.x & 63u));
    f32x4 g1a[4], b1a[4];
#pragma unroll
    for (int j = 0; j < 4; ++j) { g1a[j] = ((const f32x4*)F.in[I_LN1G])[lane + 64 * j] * ALPHA; b1a[j] = ((const f32x4*)F.in[I_LN1B])[lane + 64 * j] * ALPHA; }
    const int gw = F.vcu * 8 + F.wave, NGW = F.G * 8;
    u32x2 nh[4]; unsigned nq[4][4]; f32x4 ng; f32x2 nst;
#define P9_FETCH(tt) do { const u32x2* hp_ = (const u32x2*)(H1 + (size_t)(tt) * DM) + lane; const unsigned* yp_ = (const unsigned*)((const unsigned char*)F.out + (size_t)(tt) * 4 * DM) + lane; \
        ng = *(const f32x4*)(WSP(float, WS_TOKG) + (size_t)(tt) * 4); nst = STAT[(tt)]; \
        _Pragma("unroll") for (int j = 0; j < 4; ++j) { nh[j] = __builtin_nontemporal_load(hp_ + 64 * j); \
            _Pragma("unroll") for (int k = 0; k < 4; ++k) nq[j][k] = __builtin_nontemporal_load(yp_ + 256 * k + 64 * j); } } while (0)
    if (gw < MT) P9_FETCH(gw);
    for (int t = gw; t < MT; t += NGW) {
        const f32x4 gt = ng * (1.0f / YSCALE); const float zm = nst.x, zr = nst.y;
        u32x2 hc[4]; unsigned qc[4][4];
#pragma unroll
        for (int j = 0; j < 4; ++j) { hc[j] = nh[j];
#pragma unroll
            for (int k = 0; k < 4; ++k) qc[j][k] = nq[j][k]; }
        if (t + NGW < MT) P9_FETCH(t + NGW);
        f32x4 v[4]; float s = 0.f;
#pragma unroll
        for (int j = 0; j < 4; ++j) { const u32x2 h = hc[j];
            const unsigned q0 = qc[j][0], q1 = qc[j][1], q2 = qc[j][2], q3 = qc[j][3];
            const f32x2 a0 = __builtin_amdgcn_cvt_pk_f32_fp8(q0, false), a1 = __builtin_amdgcn_cvt_pk_f32_fp8(q0, true), b0 = __builtin_amdgcn_cvt_pk_f32_fp8(q1, false), b1 = __builtin_amdgcn_cvt_pk_f32_fp8(q1, true);
            const f32x2 c0 = __builtin_amdgcn_cvt_pk_f32_fp8(q2, false), c1 = __builtin_amdgcn_cvt_pk_f32_fp8(q2, true), d0 = __builtin_amdgcn_cvt_pk_f32_fp8(q3, false), d1 = __builtin_amdgcn_cvt_pk_f32_fp8(q3, true);
            const f32x4 hz = ((f32x4){bflo(h.x), bfhi(h.x), bflo(h.y), bfhi(h.y)} - zm) * zr * g1a[j] + b1a[j];
            v[j].x = hz.x + ((gt.x * a0.x + gt.y * b0.x) + (gt.z * c0.x + gt.w * d0.x)); v[j].y = hz.y + ((gt.x * a0.y + gt.y * b0.y) + (gt.z * c0.y + gt.w * d0.y));
            v[j].z = hz.z + ((gt.x * a1.x + gt.y * b1.x) + (gt.z * c1.x + gt.w * d1.x)); v[j].w = hz.w + ((gt.x * a1.y + gt.y * b1.y) + (gt.z * c1.y + gt.w * d1.y));
            s += (v[j].x + v[j].y) + (v[j].z + v[j].w); }
        const float mean = wave_sum(s) * (1.f / DM); float s2 = 0.f;
#pragma unroll
        for (int j = 0; j < 4; ++j) { v[j] = v[j] - mean; s2 += (v[j].x * v[j].x + v[j].y * v[j].y) + (v[j].z * v[j].z + v[j].w * v[j].w); }
        const float rstd = rsqrtf(wave_sum(s2) * (1.f / DM) + LN_EPS);
        f32x4* op = (f32x4*)(F.out + (size_t)t * DM) + lane;
#pragma unroll
        for (int j = 0; j < 4; ++j) { const f32x4 gg = ((const f32x4*)F.in[I_LN2G])[lane + 64 * j], bb = ((const f32x4*)F.in[I_LN2B])[lane + 64 * j]; __builtin_nontemporal_store(v[j] * rstd * gg + bb, op + 64 * j); }
    }
#undef P9_FETCH
}

constexpr int NPHASE = 13;
#ifndef PROBE_DOUBLE
#define PROBE_DOUBLE -1
#endif
__global__ void __launch_bounds__(512, 2) hymba_fwd(Args args) {
    extern __shared__ __attribute__((aligned(16))) unsigned char lds_raw[];
    Frame F;
    F.lds = (LAS unsigned char*)lds_raw; F.in = args.in; F.out = args.out; F.ws = args.ws;
    F.wave = __builtin_amdgcn_readfirstlane(threadIdx.x >> 6);
    F.G = gridDim.x; { const int bx = blockIdx.x; F.vcu = (F.G % 8 == 0) ? (bx % 8) * (F.G / 8) + bx / 8 : bx; }
    volatile LAS unsigned* MISC = (volatile LAS unsigned*)(F.lds + MISC_OFF);
    if (((int)threadIdx.x) < 64) MISC[((int)threadIdx.x)] = 0u;
    __syncthreads();
    XcdBarrier bar = xcd_barrier_post((unsigned*)(F.ws + WS_CTL) + CW_BAR, MISC + 8);
    const int lo = args.ph_lo, hi = args.ph_hi;
#define IN(k) (lo <= (k) && (k) < hi)
#define SEAM(k) do { if (IN(k) && IN((k) + 1)) xcd_barrier(bar); } while (0)
    if (IN(0)) { const int reps_ = (PROBE_DOUBLE == 0) ? (args.ph_hi - NPHASE + 2) : 1; for (int r_ = 0; r_ < reps_; ++r_) { p0_prologue(F); } }
    SEAM(0);
    if (IN(1)) { const int reps_ = (PROBE_DOUBLE == 1) ? (args.ph_hi - NPHASE + 2) : 1; for (int r_ = 0; r_ < reps_; ++r_) { p1_inproj(F); } }
    SEAM(1);
    if (IN(2)) { const int reps_ = (PROBE_DOUBLE == 2) ? (args.ph_hi - NPHASE + 2) : 1; for (int r_ = 0; r_ < reps_; ++r_) { ps1_ssm_e(F); } }
    SEAM(2);
    if (IN(3)) { const int reps_ = (PROBE_DOUBLE == 3) ? (args.ph_hi - NPHASE + 2) : 1; for (int r_ = 0; r_ < reps_; ++r_) {   } }
    if (IN(4)) { const int reps_ = (PROBE_DOUBLE == 4) ? (args.ph_hi - NPHASE + 2) : 1; for (int r_ = 0; r_ < reps_; ++r_) { ps3_ssm_y(F); } }
    SEAM(4);
    if (IN(5)) { const int reps_ = (PROBE_DOUBLE == 5) ? (args.ph_hi - NPHASE + 2) : 1; for (int r_ = 0; r_ < reps_; ++r_) { p3_glu(F); } }
    if (IN(6)) { const int reps_ = (PROBE_DOUBLE == 6) ? (args.ph_hi - NPHASE + 2) : 1; for (int r_ = 0; r_ < reps_; ++r_) { p6_attention_mfma(F); } }
    SEAM(6);
    if (IN(7)) { const int reps_ = (PROBE_DOUBLE == 7) ? (args.ph_hi - NPHASE + 2) : 1; for (int r_ = 0; r_ < reps_; ++r_) { p4_outproj(F); } }
    SEAM(7);
    if (IN(8)) { const int reps_ = (PROBE_DOUBLE == 8) ? (args.ph_hi - NPHASE + 2) : 1; for (int r_ = 0; r_ < reps_; ++r_) { p5_ln1_router(F); } }
    if (IN(9)) { const int reps_ = (PROBE_DOUBLE == 9) ? (args.ph_hi - NPHASE + 2) : 1; for (int r_ = 0; r_ < reps_; ++r_) { p6_dispatch(F); } }
    SEAM(9);
    if (IN(10)) { const int reps_ = (PROBE_DOUBLE == 10) ? (args.ph_hi - NPHASE + 2) : 1; for (int r_ = 0; r_ < reps_; ++r_) { p7_moe_up(F); } }
    SEAM(10);
    if (IN(11)) { const int reps_ = (PROBE_DOUBLE == 11) ? (args.ph_hi - NPHASE + 2) : 1; for (int r_ = 0; r_ < reps_; ++r_) { p8_moe_down(F); } }
    SEAM(11);
    if (IN(12)) { const int reps_ = (PROBE_DOUBLE == 12) ? (args.ph_hi - NPHASE + 2) : 1; for (int r_ = 0; r_ < reps_; ++r_) { p9_final(F); } }
#undef IN
#undef SEAM
}

#ifndef MK_N_LAUNCHES
#define MK_N_LAUNCHES 1
#endif
extern "C" void kernel_launch(void* const* d_in, const int* in_sizes, int n_in, void* d_out, int out_size, void* d_ws, size_t ws_size, hipStream_t stream) {
    static int grid = 0;
    if (grid == 0) {
        if (n_in != NIN || in_sizes[0] != MT * DM || out_size != MT * DM || ws_size < WS_END) {
            fprintf(stderr, "kernel_launch: unexpected problem (n_in %d, in0 %d, out %d, ws %zu < %zu); nothing launched\n", n_in, n_in > 0 ? in_sizes[0] : -1, out_size, ws_size, (size_t)WS_END); grid = -1; return; }
        int dev = 0, cus = 0;
        if (hipGetDevice(&dev) != hipSuccess || hipDeviceGetAttribute(&cus, hipDeviceAttributeMultiprocessorCount, dev) != hipSuccess) { grid = -1; return; }
        if (hipFuncSetAttribute((const void*)hymba_fwd, hipFuncAttributeMaxDynamicSharedMemorySize, LDS_BYTES) != hipSuccess) { fprintf(stderr, "kernel_launch: hipFuncSetAttribute failed\n"); grid = -1; return; }
        int per_cu = 0;
        if (hipOccupancyMaxActiveBlocksPerMultiprocessor(&per_cu, (const void*)hymba_fwd, 512, LDS_BYTES) != hipSuccess || per_cu < 1) { fprintf(stderr, "kernel_launch: occupancy query says %d\n", per_cu); }
        (void)hipGetLastError();
        grid = cus;
        if (grid != 256) { fprintf(stderr, "kernel_launch: built for 256 CUs, found %d; nothing launched\n", cus); grid = -1; return; }
    }
    if (grid < 0) return;
    if (hipMemsetAsync((char*)d_ws + WS_CTL, 0, CTL_ZERO_BYTES, stream) != hipSuccess) return;
    Args a{};
    for (int i = 0; i < NIN; ++i) a.in[i] = (const float*)d_in[i];
    a.out = (float*)d_out; a.ws = (unsigned char*)d_ws;
    if (MK_N_LAUNCHES == 1) { a.ph_lo = 0; a.ph_hi = NPHASE; hipLaunchKernelGGL(hymba_fwd, dim3(grid), dim3(512), LDS_BYTES, stream, a); }
    else for (int p = 0; p < NPHASE; ++p) { a.ph_lo = p; a.ph_hi = p + 1; hipLaunchKernelGGL(hymba_fwd, dim3(grid), dim3(512), LDS_BYTES, stream, a); }
}
```

```cpp
#include <hip/hip_runtime.h>
#include <cstdio>
#include <cstdint>

#define LAS __attribute__((address_space(3)))
__device__ __forceinline__ unsigned tidx() { unsigned t = threadIdx.x; asm volatile("" : "+v"(t)); return t; }
#define GAS __attribute__((address_space(1)))
typedef unsigned short bf16;
typedef float f32x4 __attribute__((ext_vector_type(4)));
typedef float f32x2 __attribute__((ext_vector_type(2)));
typedef unsigned u32x4 __attribute__((ext_vector_type(4)));
typedef unsigned u32x2 __attribute__((ext_vector_type(2)));
typedef GAS unsigned gu32;

constexpr int NB = 2, SEQ = 16384, DM = 1024, NMETA = 16;
constexpr int MT = NB * SEQ;
constexpr int XR = 256 + MT;
constexpr int NH = 4, QW = 512;
constexpr int NG = 32, SW = 512;
constexpr int NE = 32;
constexpr int NCH = 2048, CHR = 2304, AK = 384;
constexpr float LN_EPS = 1e-5f;
constexpr float ALPHA = 1.189207115002721f;
constexpr float LOG2E = 1.4426950408889634f;
constexpr float C2 = 0.125f * LOG2E;
constexpr int NIN = 34;
enum { I_X = 0, I_META, I_LNIN_G, I_LNIN_B, I_RELB, I_WIN, I_LQ1, I_LK1, I_LQ2, I_LK2, I_SUBLN, I_ARE, I_AIM, I_LOGSTEP, I_BRE, I_BIM, I_CRE, I_CIM,
       I_DSKIP, I_WGLU, I_BGLU, I_WOUT, I_LN1G, I_LN1B, I_WROUTER, I_BROUTER, I_WGATE, I_BGATE, I_WUP, I_BUP, I_WDOWN, I_BDOWN, I_LN2G, I_LN2B };

constexpr size_t MiB = 1u << 20;
constexpr size_t WS_CTL = 0, CTL_ZERO_BYTES = 32 * 1024;
constexpr size_t WS_PAR = 512 * 1024;
constexpr size_t WS_TOKE = 1 * MiB, WS_TOKG = WS_TOKE + MT * 4 * 4;
constexpr size_t WS_RT2 = 69 * MiB, WS_SD2 = 73 * MiB;
constexpr size_t WS_ROWTOK = 2 * MiB;
constexpr size_t WS_SLOTDST = WS_ROWTOK + 640 * 1024;
constexpr size_t WS_SLOTG = WS_SLOTDST + 512 * 1024;
constexpr size_t WS_CNT = WS_SLOTG + 512 * 1024;
constexpr size_t WS_WD = 4 * MiB;
constexpr size_t WS_H1Q = 36 * MiB;
constexpr size_t WS_SMALLW = 68 * MiB, WS_WTIN = 68 * MiB, WS_WTGLU = 72 * MiB, WS_WTOUT = 73 * MiB, WS_BTE = 75 * MiB, WS_BTY = 79 * MiB;
constexpr size_t WS_XN = 85 * MiB;
constexpr size_t WS_Q = 150 * MiB, WS_K = 183 * MiB, WS_V = 216 * MiB;
static_assert(WS_V - WS_K == WS_K - WS_Q, "Q/K/V equally spaced");
constexpr size_t WS_ASSM = 249 * MiB;
constexpr size_t WS_ATT = 303 * MiB;
constexpr size_t WS_STAT = 68 * MiB;
constexpr size_t WS_A2 = 152 * MiB;
static_assert((128 - 4 * 30) % 2 == 0, "R divisible by NT");
static_assert(WS_A2 >= WS_XN + (size_t)XR * DM * 2 && WS_A2 + ((size_t)MT * 4 + 256) * DM <= WS_ATT + (size_t)MT * DM * 2, "A2 placement");
constexpr size_t WS_X = 389 * MiB;
constexpr size_t WS_END = 517 * MiB;
constexpr size_t DO_E = 0, DO_G = 32 * MiB, DO_BE = 64 * MiB;

constexpr int CW_GTOT = 6144, GTOT_STRIDE = 64;
constexpr int CW_BAR = 1024;
constexpr int PF_LAM = 0, PF_A16 = 64  , PF_A256 = PF_A16 + 4096, PF_SM = PF_A256 + 4096  ;

constexpr int LDS_BYTES = 147456, MISC_OFF = 147456 - 256;

__device__ __forceinline__ float bf2f(unsigned v) { return __uint_as_float(v << 16); }
__device__ __forceinline__ unsigned f2bf(float f) { unsigned u = __float_as_uint(f); return (u + 0x7fffu + ((u >> 16) & 1u)) >> 16; }
typedef float f32x2pk __attribute__((ext_vector_type(2))); typedef __bf16 bf16x2pk __attribute__((ext_vector_type(2)));
__device__ __forceinline__ unsigned pk2(float lo, float hi) { f32x2pk v = {lo, hi}; bf16x2pk b = __builtin_convertvector(v, bf16x2pk); return __builtin_bit_cast(unsigned, b); }
__device__ __forceinline__ float bflo(unsigned w) { return __uint_as_float(w << 16); }
__device__ __forceinline__ float bfhi(unsigned w) { return __uint_as_float(w & 0xffff0000u); }
template <int CTRL> __device__ __forceinline__ float dpp_f(float x) { return __builtin_bit_cast(float, __builtin_amdgcn_update_dpp(0, __builtin_bit_cast(int, x), CTRL, 0xF, 0xF, false)); }
template <int CTRL> __device__ __forceinline__ int dpp_i(int x) { return __builtin_amdgcn_update_dpp(0, x, CTRL, 0xF, 0xF, false); }
constexpr int DPP_XOR1 = 0xB1, DPP_XOR2 = 0x4E, DPP_ROR4 = 0x124, DPP_ROR8 = 0x128, DPP_HMIRROR = 0x141, DPP_MIRROR = 0x140;
__device__ __forceinline__ float wave_sum(float v) {
    v += dpp_f<DPP_XOR1>(v); v += dpp_f<DPP_XOR2>(v); v += dpp_f<DPP_HMIRROR>(v); v += dpp_f<DPP_MIRROR>(v);
    { auto r = __builtin_amdgcn_permlane16_swap(__float_as_uint(v), __float_as_uint(v), false, false); v = __uint_as_float(r[0]) + __uint_as_float(r[1]); }
    { auto r = __builtin_amdgcn_permlane32_swap(__float_as_uint(v), __float_as_uint(v), false, false); v = __uint_as_float(r[0]) + __uint_as_float(r[1]); }
    return v;
}
__device__ __forceinline__ float sigmoidf_(float x) { return __builtin_amdgcn_rcpf(1.0f + __builtin_amdgcn_exp2f(-1.4426950408889634f * x)); }
__device__ __forceinline__ float gelu_tanh(float x) { const float z = 0.7978845608028654f * (x + 0.044715f * x * x * x); const float e = __builtin_amdgcn_exp2f(2.8853900817779268f * z); return x - x * __builtin_amdgcn_rcpf(1.0f + e); }
__device__ __forceinline__ int t5_bucket(int rel) {
    const int n = rel < 0 ? -rel : rel; int b;
    if (n < 8) b = n; else if (n < 12) b = 8; else if (n < 16) b = 9; else if (n < 23) b = 10; else if (n < 32) b = 11; else if (n < 46) b = 12; else if (n < 64) b = 13; else if (n < 91) b = 14; else b = 15;
    return b + (rel > 0 ? 16 : 0);
}

#define XB_TMO      128
#define XB_XCNT(j)  (256  + 64 * (j))
#define XB_XSUB(j)  (1280 + 64 * (j))
#define XB_XGEN(j)  (2304 + 64 * (j))
#define XB_TOP      3328
#define XB_TOPGEN   3392
#define XCD_BAR_WORDS 3456
#define XB_SPIN_CAP (1u << 22)
__device__ __forceinline__ unsigned xb_ld(unsigned* p)              { return __hip_atomic_load(p, __ATOMIC_RELAXED, __HIP_MEMORY_SCOPE_AGENT); }
__device__ __forceinline__ unsigned xb_add(unsigned* p, unsigned v) { return __hip_atomic_fetch_add(p, v, __ATOMIC_RELAXED, __HIP_MEMORY_SCOPE_AGENT); }
__device__ __forceinline__ unsigned xb_xcc_id() { return (unsigned)__builtin_amdgcn_s_getreg((3 << 11) | 20) & 0xFu; }
#define XB_SPIN(cond, bar) do { unsigned _sp = 0; while (cond) { __builtin_amdgcn_s_sleep(1); \
    if ((++_sp & 255u) == 0u) { if (xb_ld(&(bar)[XB_TMO])) break; if (_sp > XB_SPIN_CAP) { atomicAdd(&(bar)[XB_TMO], 1u); break; } } } } while (0)
struct XcdBarrier { unsigned* bar; unsigned x; volatile LAS unsigned* st; };
__device__ __forceinline__ XcdBarrier xcd_barrier_post(unsigned* bar, volatile LAS unsigned* st) {
    XcdBarrier b; b.bar = bar; b.x = xb_xcc_id(); b.st = st;
    if (tidx() == 0) (void)xb_add(&bar[XB_XCNT(b.x)], 1u);
    return b;
}
__device__ __forceinline__ void xcd_barrier_complete(unsigned* bar, unsigned x, unsigned& nloc, unsigned& nx) {
    const unsigned G = gridDim.x * gridDim.y * gridDim.z;
    unsigned sum, cnt, mine, sp = 0u;
    for (;;) {
        sum = 0u; cnt = 0u; mine = 0u;
#pragma unroll
        for (unsigned j = 0; j < 16; ++j) { const unsigned c = xb_ld(&bar[XB_XCNT(j)]); sum += c; cnt += (c > 0u) ? 1u : 0u; mine = (j == x) ? c : mine; }
        if (sum == G) break;
        __builtin_amdgcn_s_sleep(1);
        if ((++sp & 255u) == 0u) { if (xb_ld(&bar[XB_TMO])) break; if (sp > XB_SPIN_CAP) { atomicAdd(&bar[XB_TMO], 1u); break; } }
    }
    nloc = mine > 0u ? mine : 1u; nx = cnt > 0u ? cnt : 1u;
}
__device__ __forceinline__ void xcd_arrive(const XcdBarrier& b) {
    asm volatile("s_waitcnt vmcnt(0)" ::: "memory");
    __syncthreads();
    if (tidx() == 0) {
        unsigned* bar = b.bar;
        __builtin_amdgcn_s_waitcnt(0);
        unsigned nloc = b.st[0], nx = b.st[1];
        if (nloc == 0u) { xcd_barrier_complete(bar, b.x, nloc, nx); b.st[0] = nloc; b.st[1] = nx; }
        const unsigned old = xb_add(&bar[XB_XSUB(b.x)], 1u);
        const unsigned gen = old / nloc;
        b.st[2] = gen;
        if (old + 1u == (gen + 1u) * nloc) {
            __builtin_amdgcn_fence(__ATOMIC_RELEASE, "agent");
            asm volatile("s_waitcnt vmcnt(0)" ::: "memory");
            (void)xb_add(&bar[XB_TOP], 1u);
        }
    }
}
__device__ __forceinline__ void xcd_wait(const XcdBarrier& b) {
    if (tidx() == 0) {
        const unsigned gen = b.st[2], need = (gen + 1u) * b.st[1];
        XB_SPIN(xb_ld(&b.bar[XB_TOP]) < need, b.bar);
        __builtin_amdgcn_fence(__ATOMIC_ACQUIRE, "agent");
        asm volatile("s_waitcnt vmcnt(0)" ::: "memory");
    }
    __syncthreads();
}
__device__ __forceinline__ void xcd_barrier(const XcdBarrier& b) { xcd_arrive(b); xcd_wait(b); }
struct WaitMid { const XcdBarrier* b; bool on; __device__ __forceinline__ void operator()() const { if (on) xcd_wait(*b); } };

struct Args { const float* in[NIN]; float* out; unsigned char* ws; int ph_lo, ph_hi; };
struct Frame {
    LAS unsigned char* lds;
    const float* const* in; float* out; unsigned char* ws;
    int wave, vcu, G;
};
#define WSP(T, off) ((T*)(F.ws + (off)))


namespace pg8 {
typedef short bf16x8 __attribute__((ext_vector_type(8)));
constexpr int BM = 256, BK = 64, HALF = 128, HTB = HALF * BK * 2, STAGE_BYTES = 8 * HTB, NXCD = 8, WGM = 8;
__host__ __device__ __forceinline__ int lds_byte(int r, int c) { const int st = (r >> 4) * 2 + (c >> 5), rr = r & 15, cc = c & 31, ob = rr * 64 + cc * 2; return st * 1024 + (ob ^ (((ob >> 9) & 1) << 5)); }
__host__ __device__ __forceinline__ void stage_rc(int b, int& R, int& C) { const int st = b / 1024, sb = b % 1024, swz = sb ^ (((sb >> 9) & 1) << 5); R = (st >> 1) * 16 + swz / 64; C = (st & 1) * 32 + (swz % 64) / 2; }
__host__ __device__ __forceinline__ int perm32(int rho) { const int n = rho >> 4, i = rho & 15; return 8 * (i >> 2) + 4 * n + (i & 3); }
__device__ __forceinline__ unsigned cvt_pk_bf16(float lo, float hi) { unsigned r; asm volatile("v_cvt_pk_bf16_f32 %0, %1, %2" : "=v"(r) : "v"(lo), "v"(hi)); return r; }

struct GUnit { const char* A; const char* B; int i0, i1, i2, i3, i4; };
struct TileOrder {
    int nM, nN, nwg, G, c;
    __device__ void init(int nM_, int nN_, int G_, int c_) { nM = nM_; nN = nN_; nwg = nM * nN; G = G_; c = c_; }
    __device__ bool next(int i, int& pm, int& pn) const {
        const long L = (long)i * G + c; if (L >= nwg) return false;
        int wgid = (int)L; { const int q = nwg / NXCD, r = nwg % NXCD, xcd = wgid % NXCD, off = wgid / NXCD; wgid = (xcd < r ? xcd * (q + 1) : r * (q + 1) + (xcd - r) * q) + off; }
        const int nig = WGM * nN, gid = wgid / nig, fm = gid * WGM, gsz = (nM - fm) < WGM ? (nM - fm) : WGM;
        pm = fm + ((wgid % nig) % gsz); pn = (wgid % nig) / gsz; return true;
    }
};
typedef int v4i_t __attribute__((ext_vector_type(4))); typedef int v8i_t __attribute__((ext_vector_type(8)));
struct NoMid { __device__ __forceinline__ void operator()() const {} };
template <class Epi, class Sched, bool ALIGN_EPI, bool FP8 = false, class Mid = NoMid>
__device__ __forceinline__ void gemm_phase(LAS unsigned char* lds, const int KB, const Sched& S, const Epi& E, const Mid mid = Mid()) {
    const int tid = tidx(), wid = __builtin_amdgcn_readfirstlane(tid >> 6), lane = tid & 63, wr = wid >> 2, wc = wid & 3, fr = lane & 15, fq = lane >> 4;
    const int nt = KB / 128;
    unsigned voffB[2];
#pragma unroll
    for (int i = 0; i < 2; ++i) { int R, C; stage_rc(tid * 16 + i * 8192, R, C); const int Rb = Epi::PERM ? ((R & ~31) + perm32(R & 31)) : R; voffB[i] = (unsigned)(Rb * KB + C * 2); }
    const unsigned lda2 = (unsigned)S.ldab;
#define PG8_VOFFA_N(dst, un, tbn) do { _Pragma("unroll") for (int _i = 0; _i < 2; ++_i) { int _R, _C; stage_rc(tid * 16 + _i * 8192, _R, _C); \
        _Pragma("unroll") for (int _h = 0; _h < 2; ++_h) dst[_h][_i] = (unsigned)S.arow_next(un, _h * HALF + _R, lds, (tbn)) * lda2 + (unsigned)_C * 2u; } } while (0)
#define PG8_VOFFA(dst, un) do { _Pragma("unroll") for (int _i = 0; _i < 2; ++_i) { int _R, _C; stage_rc(tid * 16 + _i * 8192, _R, _C); \
        _Pragma("unroll") for (int _h = 0; _h < 2; ++_h) dst[_h][_i] = (unsigned)S.arow(un, _h * HALF + _R) * lda2 + (unsigned)_C * 2u; } } while (0)
    const size_t kstep = (size_t)(BK * 2);
    const size_t hstep = (size_t)HALF * KB;
    const unsigned ldsw = (unsigned)wid * 1024u;
    const int aoff = lds_byte(wr * 64 + fr, fq * 8), boff = lds_byte(wc * 32 + fr, fq * 8);
#define PG8_SA(b, h) (((b) * 2 + (h)) * HTB)
#define PG8_SB(b, h) ((4 + (b) * 2 + (h)) * HTB)
#define PG8_STAGE(bufoff, gbase, voff) do { _Pragma("unroll") for (int _i = 0; _i < 2; ++_i) \
        __builtin_amdgcn_global_load_lds((const unsigned*)((const char*)(gbase) + (voff)[_i]), (LAS unsigned*)(lds + (bufoff) + ldsw + _i * 8192), 16, 0, 0); } while (0)
#define PG8_LDA(dst, b, h) do { _Pragma("unroll") for (int m = 0; m < 4; ++m) _Pragma("unroll") for (int k = 0; k < 2; ++k) dst[m][k] = *(const LAS bf16x8*)(lds + PG8_SA(b, h) + aoff + m * 2048 + k * 1024); } while (0)
#define PG8_LDB(dst, b, h) do { _Pragma("unroll") for (int n = 0; n < 2; ++n) _Pragma("unroll") for (int k = 0; k < 2; ++k) dst[n][k] = *(const LAS bf16x8*)(lds + PG8_SB(b, h) + boff + n * 2048 + k * 1024); } while (0)
#define PG8_CAT(x) __builtin_shufflevector(__builtin_bit_cast(v4i_t, x[0]), __builtin_bit_cast(v4i_t, x[1]), 0, 1, 2, 3, 4, 5, 6, 7)
#define PG8_MMA(ai, bj, At, Bt) do { __builtin_amdgcn_s_setprio(1); _Pragma("unroll") for (int m = 0; m < 4; ++m) _Pragma("unroll") for (int n = 0; n < 2; ++n) { \
        if constexpr (FP8) { const v8i_t b8_ = PG8_CAT(Bt[n]), a8_ = PG8_CAT(At[m]);   \
            asm volatile("v_mfma_scale_f32_16x16x128_f8f6f4 %0, %1, %2, %0, %3, %4 op_sel_hi:[0,0,0]" : "+v"(acc[ai][bj][m][n]) : "v"(b8_), "v"(a8_), "v"(sclW), "v"(sclX)); } \
        else { _Pragma("unroll") for (int k = 0; k < 2; ++k) acc[ai][bj][m][n] = __builtin_amdgcn_mfma_f32_16x16x32_bf16(Bt[n][k], At[m][k], acc[ai][bj][m][n], 0, 0, 0); } } \
        __builtin_amdgcn_s_setprio(0); } while (0)
#define PG8_WAIT_V(n) asm volatile("s_waitcnt vmcnt(" #n ")" ::: "memory")
#define PG8_WAIT_L(n) asm volatile("s_waitcnt lgkmcnt(" #n ")" ::: "memory")
#define PG8_BAR __builtin_amdgcn_s_barrier()
#define PG8_SCHED __builtin_amdgcn_sched_barrier(0)
    const int sclW = 122, sclX = 127;
    GUnit cur; int ui = 0;
    if (!S.next(0, cur)) { mid(); return; }
    int tb = 0;
    if constexpr (Epi::PREFETCH) E.prefetch(lds, cur, 0, wid, lane);
    unsigned voffA[2][2], nvoffA[2][2];
    PG8_VOFFA(voffA, cur);
    f32x4 acc[2][2][4][2];
#pragma unroll
    for (int a = 0; a < 2; ++a)
#pragma unroll
        for (int b = 0; b < 2; ++b)
#pragma unroll
            for (int m = 0; m < 4; ++m)
#pragma unroll
                for (int n = 0; n < 2; ++n) acc[a][b][m][n] = (f32x4){0.f, 0.f, 0.f, 0.f};
    bf16x8 At[4][2], B0[2][2], B1[2][2];
    const char* cA = cur.A; const char* cB = cur.B;
    PG8_STAGE(PG8_SB(0, 0), cB, voffB); PG8_STAGE(PG8_SB(0, 1), cB + hstep, voffB); mid(); PG8_STAGE(PG8_SA(0, 0), cA, voffA[0]); PG8_STAGE(PG8_SA(0, 1), cA, voffA[1]);
    if (wr == 1) PG8_BAR;
    PG8_WAIT_V(2); PG8_BAR;
    PG8_STAGE(PG8_SB(1, 0), cB + kstep, voffB); PG8_STAGE(PG8_SA(1, 0), cA + kstep, voffA[0]); PG8_STAGE(PG8_SB(1, 1), cB + hstep + kstep, voffB);
    PG8_WAIT_V(6); PG8_BAR;
    for (;;) {
        const char* nA = cA; const char* nB = cB; bool has_next;
        GUnit nxt; has_next = S.next(ui + 1, nxt);
        if (has_next) { nA = nxt.A; nB = nxt.B; if constexpr (Epi::PREFETCH) E.prefetch(lds, nxt, tb == 2 ? 0 : tb + 1, wid, lane); }
#pragma unroll
        for (int h = 0; h < 2; ++h)
#pragma unroll
            for (int i = 0; i < 2; ++i) nvoffA[h][i] = voffA[h][i];
#pragma nounroll
        for (int t = 0; t < nt; t += 2) {
            const bool last = (t == nt - 2);
            if (last && has_next) { PG8_VOFFA_N(nvoffA, nxt, (tb == 2 ? 0 : tb + 1)); }
            const char* a1 = cA + (size_t)(t + 1) * kstep;
            const char* a2 = last ? nA : cA + (size_t)(t + 2) * kstep; const char* b2 = last ? nB : cB + (size_t)(t + 2) * kstep;
            const char* a3 = a2 + kstep; const char* b3 = b2 + kstep;
            unsigned vA2[2][2];
#pragma unroll
            for (int h = 0; h < 2; ++h)
#pragma unroll
                for (int i = 0; i < 2; ++i) vA2[h][i] = last ? nvoffA[h][i] : voffA[h][i];
            PG8_LDB(B0, 0, 0); PG8_LDB(B1, 0, 1); PG8_SCHED; PG8_LDA(At, 0, 0); PG8_STAGE(PG8_SA(1, 1), a1, voffA[1]);
            PG8_WAIT_V(8); PG8_WAIT_L(0); PG8_BAR; PG8_MMA(0, 0, At, B0); PG8_MMA(0, 1, At, B1); PG8_BAR; PG8_SCHED;
            PG8_LDA(At, 0, 1); PG8_STAGE(PG8_SB(0, 0), b2, voffB); PG8_STAGE(PG8_SB(0, 1), b2 + hstep, voffB); PG8_STAGE(PG8_SA(0, 0), a2, vA2[0]);
            PG8_WAIT_V(8); PG8_WAIT_L(0); PG8_BAR; PG8_MMA(1, 0, At, B0); PG8_MMA(1, 1, At, B1); PG8_BAR; PG8_SCHED;
            PG8_LDB(B0, 1, 0); PG8_LDB(B1, 1, 1); PG8_SCHED; PG8_LDA(At, 1, 0); PG8_STAGE(PG8_SA(0, 1), a2, vA2[1]);
            PG8_WAIT_V(8); PG8_WAIT_L(0); PG8_BAR; PG8_MMA(0, 0, At, B0); PG8_MMA(0, 1, At, B1); PG8_BAR; PG8_SCHED;
            PG8_LDA(At, 1, 1); PG8_STAGE(PG8_SB(1, 0), b3, voffB); PG8_STAGE(PG8_SB(1, 1), b3 + hstep, voffB); PG8_STAGE(PG8_SA(1, 0), a3, vA2[0]);
            PG8_WAIT_V(8); PG8_WAIT_L(0); PG8_BAR; PG8_MMA(1, 0, At, B0); PG8_MMA(1, 1, At, B1); PG8_BAR; PG8_SCHED;
        }
        if constexpr (FP8) { asm volatile("s_nop 15\n\ts_nop 15" ::: "memory"); PG8_SCHED; }
        if constexpr (ALIGN_EPI) { if (wr == 0) PG8_BAR; }
        if constexpr (Epi::PREFETCH) E(acc, cur, wr, wc, fr, fq, lds, tb); else E(acc, cur, wr, wc, fr, fq);
        if (!has_next) break;
        tb = (tb == 2) ? 0 : tb + 1;
#pragma unroll
        for (int a = 0; a < 2; ++a)
#pragma unroll
            for (int b = 0; b < 2; ++b)
#pragma unroll
                for (int m = 0; m < 4; ++m)
#pragma unroll
                    for (int n = 0; n < 2; ++n) acc[a][b][m][n] = (f32x4){0.f, 0.f, 0.f, 0.f};
        ++ui; (void)S.next(ui, cur); cA = nA; cB = nB;
#pragma unroll
        for (int h = 0; h < 2; ++h)
#pragma unroll
            for (int i = 0; i < 2; ++i) voffA[h][i] = nvoffA[h][i];
        if constexpr (ALIGN_EPI) { if (wr == 1) PG8_BAR; }
    }
    PG8_WAIT_V(0);
    if constexpr (!ALIGN_EPI) { if (wr == 0) PG8_BAR; }
    PG8_BAR;
#undef PG8_VOFFA
#undef PG8_VOFFA_N
#undef PG8_SA
#undef PG8_SB
#undef PG8_STAGE
#undef PG8_LDA
#undef PG8_LDB
#undef PG8_MMA
#undef PG8_CAT
#undef PG8_WAIT_V
#undef PG8_WAIT_L
#undef PG8_BAR
#undef PG8_SCHED
}
}
using pg8::GUnit;

struct DenseSched {
    pg8::TileOrder ord; const char* A; const char* Bt; int lda, K, rowoff, ldab;
    __device__ __forceinline__ bool next(int i, GUnit& u) const { int pm, pn; if (!ord.next(i, pm, pn)) return false; u.A = A; u.B = Bt + (size_t)pn * 256 * K * 2; u.i0 = pm; u.i1 = pn; u.i2 = 0; u.i3 = 0; u.i4 = 0; return true; }
    __device__ __forceinline__ int arow(const GUnit& u, int r) const { return u.i0 * 256 + r + rowoff; }
    __device__ __forceinline__ int arow_next(const GUnit& u, int r, const LAS unsigned char*, int) const { return arow(u, r); }
};

__device__ __forceinline__ void ln_row_bf16(const float* xrow, const float* g, const float* bt, bf16* orow, int lane) {
    const f32x4* xr = (const f32x4*)xrow + lane;
    f32x4 v[4]; float s = 0.f;
#pragma unroll
    for (int j = 0; j < 4; ++j) { v[j] = __builtin_nontemporal_load(xr + 64 * j); s += (v[j].x + v[j].y) + (v[j].z + v[j].w); }
    const float mean = wave_sum(s) * (1.f / DM); float s2 = 0.f;
#pragma unroll
    for (int j = 0; j < 4; ++j) { v[j] = v[j] - mean; s2 += (v[j].x * v[j].x + v[j].y * v[j].y) + (v[j].z * v[j].z + v[j].w * v[j].w); }
    const float rstd = rsqrtf(wave_sum(s2) * (1.f / DM) + LN_EPS);
    u32x2* o8 = (u32x2*)orow + lane;
#pragma unroll
    for (int j = 0; j < 4; ++j) {
        const f32x4 gg = ((const f32x4*)g)[lane + 64 * j], bb = ((const f32x4*)bt)[lane + 64 * j];
        const f32x4 y = v[j] * rstd * gg + bb;
        u32x2 w; w.x = pk2(y.x, y.y); w.y = pk2(y.z, y.w); o8[64 * j] = w;
    }
}

__device__ __forceinline__ void p0_transpose_item(const float* W, int ldw, int k0, int n0, bf16* WT, int ldt, int drow0, LAS float* scr, int lane) {
    {
        f32x4 v[8];
#pragma unroll
        for (int i = 0; i < 8; ++i) v[i] = __builtin_nontemporal_load((const f32x4*)(W + (size_t)(k0 + 8 * i + (lane >> 3)) * ldw + n0 + (lane & 7) * 4));
#pragma unroll
        for (int i = 0; i < 8; ++i) { LAS float* d = scr + (8 * i + (lane >> 3)) * 33 + (lane & 7) * 4; d[0] = v[i].x; d[1] = v[i].y; d[2] = v[i].z; d[3] = v[i].w; }
    }
    asm volatile("s_waitcnt lgkmcnt(0)" ::: "memory");
    const int c = lane & 7;
#pragma unroll
    for (int j = 0; j < 4; ++j) { const int n = (lane >> 3) + 8 * j; const LAS float* sp = scr + (8 * c) * 33 + n;
        u32x4 o; o.x = pk2(sp[0 * 33], sp[1 * 33]); o.y = pk2(sp[2 * 33], sp[3 * 33]); o.z = pk2(sp[4 * 33], sp[5 * 33]); o.w = pk2(sp[6 * 33], sp[7 * 33]);
        __builtin_nontemporal_store(o, (u32x4*)(WT + (size_t)(drow0 + n) * ldt + k0 + 8 * c)); }
    asm volatile("s_waitcnt lgkmcnt(0)" ::: "memory");
}
__device__ __forceinline__ void p0_transpose_item_fp8(const float* W, int ldw, int k0, int n0, unsigned char* WT, int ldt, int drow0, LAS float* scr, int lane) {
    {   f32x4 v[16];
#pragma unroll
        for (int i = 0; i < 16; ++i) v[i] = __builtin_nontemporal_load((const f32x4*)(W + (size_t)(k0 + 8 * i + (lane >> 3)) * ldw + n0 + (lane & 7) * 4));
#pragma unroll
        for (int i = 0; i < 16; ++i) { LAS float* d = scr + (8 * i + (lane >> 3)) * 33 + (lane & 7) * 4; d[0] = v[i].x * 32.0f; d[1] = v[i].y * 32.0f; d[2] = v[i].z * 32.0f; d[3] = v[i].w * 32.0f; }
    }
    asm volatile("s_waitcnt lgkmcnt(0)" ::: "memory");
    const int c = lane & 7;
#pragma unroll
    for (int j = 0; j < 4; ++j) { const int n = (lane >> 3) + 8 * j; const LAS float* sp = scr + (16 * c) * 33 + n;
        u32x4 o;
        o.x = __builtin_amdgcn_cvt_pk_fp8_f32(sp[0 * 33], sp[1 * 33], 0, false);   o.x = __builtin_amdgcn_cvt_pk_fp8_f32(sp[2 * 33], sp[3 * 33], o.x, true);
        o.y = __builtin_amdgcn_cvt_pk_fp8_f32(sp[4 * 33], sp[5 * 33], 0, false);   o.y = __builtin_amdgcn_cvt_pk_fp8_f32(sp[6 * 33], sp[7 * 33], o.y, true);
        o.z = __builtin_amdgcn_cvt_pk_fp8_f32(sp[8 * 33], sp[9 * 33], 0, false);   o.z = __builtin_amdgcn_cvt_pk_fp8_f32(sp[10 * 33], sp[11 * 33], o.z, true);
        o.w = __builtin_amdgcn_cvt_pk_fp8_f32(sp[12 * 33], sp[13 * 33], 0, false); o.w = __builtin_amdgcn_cvt_pk_fp8_f32(sp[14 * 33], sp[15 * 33], o.w, true);
        __builtin_nontemporal_store(o, (u32x4*)(WT + (size_t)(drow0 + n) * ldt + k0 + 16 * c)); }
    asm volatile("s_waitcnt lgkmcnt(0)" ::: "memory");
}
__device__ __forceinline__ void p0_weights(Frame& F, int r_lo, int r_hi) {
    LAS float* scr = (LAS float*)(F.lds + F.wave * 17408);
    const int lane = (int)(tidx() & 63u);
    const int gw = F.vcu * 8 + F.wave, NGW = F.G * 8;
    constexpr int NEXP = 96 * 256, NALL = NEXP + 1024 + 128 + 512;
    (void)NALL;
    for (int r0 = r_lo + gw; r0 < r_hi; r0 += NGW) {
        int r = r0;
        if (r < 1024) { const int kb = r >> 6, nb = r & 63; p0_transpose_item(F.in[I_WIN], 2048, kb * 64, nb * 32, WSP(bf16, WS_WTIN), DM, nb * 32, scr, lane); continue; } r -= 1024;
        if (r < 128) { const int kb = r >> 4, nb = r & 15; p0_transpose_item(F.in[I_WGLU], SW, kb * 64, nb * 32, WSP(bf16, WS_WTGLU), SW, nb * 32, scr, lane); continue; } r -= 128;
        { const int kb = r >> 5, nb = r & 31; p0_transpose_item(F.in[I_WOUT], DM, kb * 64, nb * 32, WSP(bf16, WS_WTOUT), DM, nb * 32, scr, lane); }
    }
}
constexpr int ATT_NT = 2, ATT_NA = 32 - ATT_NT, ATT_NTW = 64 * ATT_NT;
__device__ __forceinline__ void p0_expert_stream(Frame& F, int tw, int j0, int j1) {
    const int lane = (int)(tidx() & 63u), g = lane >> 3, c4 = (lane & 7) * 4;
    const float* bg = F.in[I_WGATE]; const long ou = (long)(F.in[I_WUP] - bg), od = (long)(F.in[I_WDOWN] - bg);
    f32x4 A[16], B[16], C[16];
#define XS_LOAD(buf, j_) do { if ((j_) < j1) { const int it_ = tw + ATT_NTW * (j_), mat_ = it_ >> 8, r_ = it_ & 255, e_ = mat_ / 3, w_ = mat_ - 3 * e_, kb_ = r_ >> 5, nb_ = r_ & 31; \
        const float* sp_ = bg + (long)(w_ == 1) * ou + (long)(w_ == 2) * od + (size_t)e_ * DM * DM + (size_t)(kb_ * 128 + 16 * g) * DM + nb_ * 32 + c4; \
        _Pragma("unroll") for (int i = 0; i < 16; ++i) buf[i] = __builtin_nontemporal_load((const f32x4*)(sp_ + (size_t)i * DM)); } } while (0)
#define XS_PK(buf, q, cc) ({ int o_ = __builtin_amdgcn_cvt_pk_fp8_f32(buf[4 * (q)][cc] * 32.0f, buf[4 * (q) + 1][cc] * 32.0f, 0, false); (unsigned)__builtin_amdgcn_cvt_pk_fp8_f32(buf[4 * (q) + 2][cc] * 32.0f, buf[4 * (q) + 3][cc] * 32.0f, o_, true); })
#define XS_PROC(buf, j_) do { if ((j_) < j1) { const int it_ = tw + ATT_NTW * (j_), mat_ = it_ >> 8, r_ = it_ & 255, e_ = mat_ / 3, w_ = mat_ - 3 * e_, kb_ = r_ >> 5, nb_ = r_ & 31, n0_ = nb_ * 32; \
          \
        unsigned char* wt_ = F.ws + ((w_ == 2) ? (WS_WD + (size_t)e_ * DM * DM) : (WS_X + (size_t)e_ * 2048 * DM)); \
        const int dr_ = ((w_ == 2) ? n0_ : ((n0_ >> 7) * 256 + w_ * 128 + (n0_ & 127))) + c4; \
        _Pragma("unroll") for (int cc = 0; cc < 4; ++cc) { u32x4 o; o.x = XS_PK(buf, 0, cc); o.y = XS_PK(buf, 1, cc); o.z = XS_PK(buf, 2, cc); o.w = XS_PK(buf, 3, cc); \
            __builtin_nontemporal_store(o, (u32x4*)(wt_ + (size_t)(dr_ + cc) * DM + kb_ * 128 + 16 * g)); } } } while (0)
    XS_LOAD(A, j0); XS_LOAD(B, j0 + 1);
#pragma nounroll
    for (int j = j0; j < j1; j += 3) {
        XS_LOAD(C, j + 2); XS_PROC(A, j);
        XS_LOAD(A, j + 3); XS_PROC(B, j + 1);
        XS_LOAD(B, j + 4); XS_PROC(C, j + 2);
    }
#undef XS_LOAD
#undef XS_PK
#undef XS_PROC
}

__device__ __forceinline__ void cpow(float step, float ar, float ai, int d, float& re, float& im) {
    const float mag = __expf((float)d * step * ar);
    const double rev = (double)d * (double)step * (double)ai * 0.15915494309189535; const float fr = (float)(rev - __builtin_floor(rev + 0.5));
    re = mag * __builtin_amdgcn_cosf(fr); im = mag * __builtin_amdgcn_sinf(fr);
}
__device__ __forceinline__ void p0_ssm_tables(Frame& F, int g) {
    LAS float* Pw = (LAS float*)F.lds;
    LAS float* Bb = Pw + 64 * 17 * 2;
    LAS float* Cc = Bb + 64 * 16 * 2;
    LAS float* Md = Cc + 16 * 64 * 2;
    float* PAR = WSP(float, WS_PAR);
    __syncthreads();
    if (((int)tidx()) < 64) {
        const int n = ((int)tidx()), gn = g * 64 + n;
        const float step = __expf(F.in[I_LOGSTEP][g]);
        const float ar = fminf(F.in[I_ARE][gn], -1e-4f), ai = F.in[I_AIM][gn];
        for (int d = 0; d <= 16; ++d) { float re, im; cpow(step, ar, ai, d, re, im); Pw[(n * 17 + d) * 2] = re; Pw[(n * 17 + d) * 2 + 1] = im; }
        float abr, abi; cpow(step, ar, ai, 1, abr, abi);
        const float den = ar * ar + ai * ai, ere = abr - 1.0f, eim = abi;
        const float fre = (ere * ar + eim * ai) / den, fim = (eim * ar - ere * ai) / den;
        for (int c = 0; c < 16; ++c) { const float br = F.in[I_BRE][gn * 16 + c], bi = F.in[I_BIM][gn * 16 + c];
            Bb[(n * 16 + c) * 2] = fre * br - fim * bi; Bb[(n * 16 + c) * 2 + 1] = fre * bi + fim * br; }
        float re, im; cpow(step, ar, ai, 16, re, im); PAR[PF_A16 + gn * 2] = re; PAR[PF_A16 + gn * 2 + 1] = im;
        cpow(step, ar, ai, 256, re, im); PAR[PF_A256 + gn * 2] = re; PAR[PF_A256 + gn * 2 + 1] = im;
    }
    for (int i = ((int)tidx()); i < 1024; i += 512) { Cc[i * 2] = F.in[I_CRE][g * 1024 + i]; Cc[i * 2 + 1] = F.in[I_CIM][g * 1024 + i]; }
    __syncthreads();
    {
        const int d = ((int)tidx()) >> 5, c = (((int)tidx()) >> 1) & 15, h = ((int)tidx()) & 1; float acc[8];
#pragma unroll
        for (int j = 0; j < 8; ++j) acc[j] = 0.f;
        for (int n = 0; n < 64; ++n) { const float cr = Cc[(c * 64 + n) * 2], ci = Cc[(c * 64 + n) * 2 + 1], pr = Pw[(n * 17 + d) * 2], pi = Pw[(n * 17 + d) * 2 + 1];
            const float qr = cr * pr - ci * pi, qi = cr * pi + ci * pr; const LAS float* bb = Bb + (n * 16 + h * 8) * 2;
#pragma unroll
            for (int j = 0; j < 8; ++j) acc[j] += qr * bb[2 * j] - qi * bb[2 * j + 1]; }
#pragma unroll
        for (int j = 0; j < 8; ++j) { const int cp = h * 8 + j; Md[(d * 16 + c) * 16 + cp] = acc[j] + ((d == 0 && c == cp) ? F.in[I_DSKIP][g * 16 + c] : 0.f); }
    }
    __syncthreads();
    {
        const int R = ((int)tidx()) >> 1, i = R >> 4, c = R & 15, k0 = (((int)tidx()) & 1) * 192; bf16* dst = WSP(bf16, WS_BTY) + ((size_t)g * 256 + R) * AK + k0;
        for (int q = 0; q < 24; ++q) { float v[8];
#pragma unroll
            for (int e = 0; e < 8; ++e) { const int k = k0 + q * 8 + e; float val;
                if (k < 256) { const int j = k >> 4, cp = k & 15; val = (j <= i) ? Md[((i - j) * 16 + c) * 16 + cp] : 0.f; }
                else { const int n = (k - 256) & 63; const float cr = Cc[(c * 64 + n) * 2], ci = Cc[(c * 64 + n) * 2 + 1], pr = Pw[(n * 17 + i + 1) * 2], pi = Pw[(n * 17 + i + 1) * 2 + 1];
                    val = (k < 320) ? (cr * pr - ci * pi) : -(cr * pi + ci * pr); }
                v[e] = val; }
            u32x4 w; w.x = pk2(v[0], v[1]); w.y = pk2(v[2], v[3]); w.z = pk2(v[4], v[5]); w.w = pk2(v[6], v[7]); *(u32x4*)(dst + q * 8) = w; }
    }
    {
        const int R = ((int)tidx()) >> 1, n = R & 63, k0 = (((int)tidx()) & 1) * 128; bf16* dst = WSP(bf16, WS_BTE) + ((size_t)g * 256 + R) * 256 + k0;
        for (int q = 0; q < 16; ++q) { float v[8];
#pragma unroll
            for (int e = 0; e < 8; ++e) { const int k = k0 + q * 8 + e, j = k >> 4, cp = k & 15;
                const float pr = Pw[(n * 17 + 15 - j) * 2], pi = Pw[(n * 17 + 15 - j) * 2 + 1], br = Bb[(n * 16 + cp) * 2], bi = Bb[(n * 16 + cp) * 2 + 1];
                v[e] = (R < 64) ? (pr * br - pi * bi) : (R < 128) ? (pr * bi + pi * br) : 0.f; }
            u32x4 w; w.x = pk2(v[0], v[1]); w.y = pk2(v[2], v[3]); w.z = pk2(v[4], v[5]); w.w = pk2(v[6], v[7]); *(u32x4*)(dst + q * 8) = w; }
    }
    __syncthreads();
}
__device__ __forceinline__ void p0_prologue(Frame& F) {
    p0_weights(F, 0, 1024);
    if ((F.vcu & 7) == 0) p0_ssm_tables(F, F.vcu >> 3);
    else {
        const int lane = (int)(tidx() & 63u), gwp = (F.vcu - (F.vcu >> 3) - 1) * 8 + F.wave, NGWP = (F.G - F.G / 8) * 8, nrow = NMETA + MT;
        const float* xb = F.in[I_X]; const long moff = (long)(F.in[I_META] - F.in[I_X]);
        bf16* XN = WSP(bf16, WS_XN);
        f32x4 nx[4], ny[4];
#define P0_ROWPTR(q_) ((const f32x4*)(xb + (((q_) < NMETA) ? moff + (long)(q_) * DM : (long)((q_) - NMETA) * DM)) + lane)
        if (gwp < nrow) { const f32x4* xr = P0_ROWPTR(gwp);
#pragma unroll
            for (int j = 0; j < 4; ++j) nx[j] = __builtin_nontemporal_load(xr + 64 * j); }
        if (gwp + NGWP < nrow) { const f32x4* xr = P0_ROWPTR(gwp + NGWP);
#pragma unroll
            for (int j = 0; j < 4; ++j) ny[j] = __builtin_nontemporal_load(xr + 64 * j); }
        for (int q = gwp; q < nrow; q += NGWP) {
            f32x4 v[4]; float s = 0.f;
#pragma unroll
            for (int j = 0; j < 4; ++j) { v[j] = nx[j]; nx[j] = ny[j]; s += (v[j].x + v[j].y) + (v[j].z + v[j].w); }
            const int qn = q + 2 * NGWP;
            if (qn < nrow) { const f32x4* xr = P0_ROWPTR(qn);
#pragma unroll
                for (int j = 0; j < 4; ++j) ny[j] = __builtin_nontemporal_load(xr + 64 * j); }
            const float mean = wave_sum(s) * (1.f / DM); float s2 = 0.f;
#pragma unroll
            for (int j = 0; j < 4; ++j) { v[j] = v[j] - mean; s2 += (v[j].x * v[j].x + v[j].y * v[j].y) + (v[j].z * v[j].z + v[j].w * v[j].w); }
            const float rstd = rsqrtf(wave_sum(s2) * (1.f / DM) + LN_EPS);
            u32x2* o8 = (u32x2*)(XN + (size_t)((q < NMETA) ? q : q + (256 - NMETA)) * DM) + lane;
#pragma unroll
            for (int j = 0; j < 4; ++j) { const f32x4 gg = ((const f32x4*)F.in[I_LNIN_G])[lane + 64 * j], bb = ((const f32x4*)F.in[I_LNIN_B])[lane + 64 * j];
                const f32x4 y = v[j] * rstd * gg + bb; u32x2 w; w.x = pk2(y.x, y.y); w.y = pk2(y.z, y.w); o8[64 * j] = w; }
        }
    }
    float* PAR = WSP(float, WS_PAR);
    if (blockIdx.x == 0 && ((int)tidx()) < 64) {
        const int i = (int)tidx();
        const float s1 = wave_sum(F.in[I_LQ1][i] * F.in[I_LK1][i]), s2 = wave_sum(F.in[I_LQ2][i] * F.in[I_LK2][i]);
        if (i == 0) PAR[PF_LAM] = expf(s1) - expf(s2) + 0.2f;
    }
    if (blockIdx.x == 1 && ((int)tidx()) < 256) WSP(int, WS_ROWTOK)[MT * 4 + ((int)tidx())] = 0;
}


constexpr float QSCALE = 16.0f, KSCALE = 2.0f;
constexpr float VSCALE = 4.0f;
struct EpiInProj {
    static constexpr bool PERM = true; static constexpr bool PREFETCH = false; bf16 *Q, *Kb, *V, *AS;
    __device__ __forceinline__ void operator()(const f32x4 (&acc)[2][2][4][2], const GUnit& u, int wr, int wc, int fr, int fq) const {
        const int pm = u.i0, pn = u.i1, sel = pn >> 1, colb = (pn & 1) * 256 + wc * 32 + 8 * fq;
        const float sc = (sel == 0) ? C2 : 1.0f;
#pragma unroll
        for (int ai = 0; ai < 2; ++ai)
#pragma unroll
            for (int m = 0; m < 4; ++m) {
                const int r = 256 + pm * 256 + ai * 128 + wr * 64 + m * 16 + fr;
                const int ch = (r - 256) >> 4, j = (r - 256) & 15;
#pragma unroll
                for (int bj = 0; bj < 2; ++bj) {
                    const f32x4 v0 = acc[ai][bj][m][0] * sc, v1 = acc[ai][bj][m][1] * sc; const int c = colb + bj * 128;
                    u32x4 w; w.x = pg8::cvt_pk_bf16(v0[0], v0[1]); w.y = pg8::cvt_pk_bf16(v0[2], v0[3]); w.z = pg8::cvt_pk_bf16(v1[0], v1[1]); w.w = pg8::cvt_pk_bf16(v1[2], v1[3]);
                    if (sel < 2) { const float s8 = (sel == 0) ? QSCALE : KSCALE; unsigned char* base = (unsigned char*)Q + (size_t)sel * (WS_K - WS_Q); u32x2 q8;
                        q8.x = __builtin_amdgcn_cvt_pk_fp8_f32(v0[0] * s8, v0[1] * s8, 0, false); q8.x = __builtin_amdgcn_cvt_pk_fp8_f32(v0[2] * s8, v0[3] * s8, q8.x, true);
                        q8.y = __builtin_amdgcn_cvt_pk_fp8_f32(v1[0] * s8, v1[1] * s8, 0, false); q8.y = __builtin_amdgcn_cvt_pk_fp8_f32(v1[2] * s8, v1[3] * s8, q8.y, true);
                        *(u32x2*)(base + (size_t)r * QW + c) = q8; }
                    else if (sel == 2) { u32x2 q8; q8.x = __builtin_amdgcn_cvt_pk_fp8_f32(v0[0] * VSCALE, v0[1] * VSCALE, 0, false); q8.x = __builtin_amdgcn_cvt_pk_fp8_f32(v0[2] * VSCALE, v0[3] * VSCALE, q8.x, true);
                        q8.y = __builtin_amdgcn_cvt_pk_fp8_f32(v1[0] * VSCALE, v1[1] * VSCALE, 0, false); q8.y = __builtin_amdgcn_cvt_pk_fp8_f32(v1[2] * VSCALE, v1[3] * VSCALE, q8.y, true);
                        *(u32x2*)((unsigned char*)V + (size_t)r * QW + c) = q8; }
                    else *(u32x4*)(AS + ((size_t)(c >> 4) * CHR + ch) * AK + j * 16 + (c & 15)) = w;
                }
            }
    }
};
__device__ __forceinline__ void p1_meta(Frame& F) {
    const int tid = tidx(), o = tid >> 2, sub = tid & 3, row = o >> 3, n = F.vcu * 8 + (o & 7);
    if (F.vcu >= 256) return;
    const bf16* xp = WSP(bf16, WS_XN) + (size_t)row * DM + sub * 256; const bf16* wp = WSP(bf16, WS_WTIN) + (size_t)n * DM + sub * 256;
    float acc = 0.f;
#pragma unroll 16
    for (int k = 0; k < 256; k += 8) { const u32x4 a = *(const u32x4*)(xp + k), w = *(const u32x4*)(wp + k);
        acc += (bflo(a.x) * bflo(w.x) + bfhi(a.x) * bfhi(w.x)) + (bflo(a.y) * bflo(w.y) + bfhi(a.y) * bfhi(w.y)) + (bflo(a.z) * bflo(w.z) + bfhi(a.z) * bfhi(w.z)) + (bflo(a.w) * bflo(w.w) + bfhi(a.w) * bfhi(w.w)); }
    acc += __shfl_xor(acc, 1); acc += __shfl_xor(acc, 2);
    if (sub == 0) {
        if (n < 512) (F.ws + WS_Q)[(size_t)row * QW + n] = (unsigned char)(__builtin_amdgcn_cvt_pk_fp8_f32(acc * (C2 * QSCALE), 0.f, 0, false) & 255);
        else if (n < 1024) (F.ws + WS_K)[(size_t)row * QW + n - 512] = (unsigned char)(__builtin_amdgcn_cvt_pk_fp8_f32(acc * KSCALE, 0.f, 0, false) & 255);
        else if (n < 1536) (F.ws + WS_V)[(size_t)row * QW + n - 1024] = (unsigned char)(__builtin_amdgcn_cvt_pk_fp8_f32(acc * VSCALE, 0.f, 0, false) & 255);
        else { const int c = n - 1536; WSP(bf16, WS_ASSM)[((size_t)(c >> 4) * CHR + NCH) * AK + row * 16 + (c & 15)] = (bf16)f2bf(acc); }
    }
}
__device__ __forceinline__ void p1_inproj(Frame& F) {
    p1_meta(F);
    DenseSched S; S.ord.init(MT / 256, 8, F.G, (int)blockIdx.x); S.A = (const char*)WSP(bf16, WS_XN); S.Bt = (const char*)WSP(bf16, WS_WTIN); S.lda = DM; S.K = DM; S.rowoff = 256; S.ldab = DM * 2;
    EpiInProj E{WSP(bf16, WS_Q), WSP(bf16, WS_K), WSP(bf16, WS_V), WSP(bf16, WS_ASSM)};
    pg8::gemm_phase<EpiInProj, DenseSched, true>(F.lds, DM * 2, S, E);
}
struct EpiGlu {
    static constexpr bool PERM = true; static constexpr bool PREFETCH = false; const bf16* G; const float* bias; bf16* ATT;
    __device__ __forceinline__ void operator()(const f32x4 (&acc)[2][2][4][2], const GUnit& u, int wr, int wc, int fr, int fq) const {
        const int pm = u.i0, pn = u.i1;
#pragma unroll
        for (int bj = 0; bj < 2; ++bj) {
            const int c = pn * 256 + bj * 128 + wc * 32 + 8 * fq;
            const f32x4 b0 = *(const f32x4*)(bias + c), b1 = *(const f32x4*)(bias + c + 4);
#pragma unroll
            for (int ai = 0; ai < 2; ++ai)
#pragma unroll
                for (int m = 0; m < 4; ++m) {
                    const int r = pm * 256 + ai * 128 + wr * 64 + m * 16 + fr;
                    const u32x4 gv = __builtin_nontemporal_load((const u32x4*)(G + (size_t)r * SW + c));
                    const f32x4 v0 = acc[ai][bj][m][0] + b0, v1 = acc[ai][bj][m][1] + b1;
                    u32x4 w; w.x = pg8::cvt_pk_bf16(bflo(gv.x) * sigmoidf_(v0[0]), bfhi(gv.x) * sigmoidf_(v0[1])); w.y = pg8::cvt_pk_bf16(bflo(gv.y) * sigmoidf_(v0[2]), bfhi(gv.y) * sigmoidf_(v0[3]));
                    w.z = pg8::cvt_pk_bf16(bflo(gv.z) * sigmoidf_(v1[0]), bfhi(gv.z) * sigmoidf_(v1[1])); w.w = pg8::cvt_pk_bf16(bflo(gv.w) * sigmoidf_(v1[2]), bfhi(gv.w) * sigmoidf_(v1[3]));
                    *(u32x4*)(ATT + (size_t)r * DM + 512 + c) = w;
                }
        }
    }
};
__device__ __forceinline__ void p3_glu(Frame& F) {
    DenseSched S; S.ord.init(MT / 256, 2, F.G, (int)blockIdx.x); S.A = (const char*)F.out + DO_G; S.Bt = (const char*)WSP(bf16, WS_WTGLU); S.lda = SW; S.K = SW; S.rowoff = 0; S.ldab = SW * 2;
    EpiGlu E{(const bf16*)((const unsigned char*)F.out + DO_G), F.in[I_BGLU], WSP(bf16, WS_ATT)};
    pg8::gemm_phase<EpiGlu, DenseSched, true>(F.lds, SW * 2, S, E);
}
struct EpiOutProj {
    static constexpr bool PERM = true; static constexpr bool PREFETCH = false; const bf16* XN; bf16* Z;
    __device__ __forceinline__ void operator()(const f32x4 (&acc)[2][2][4][2], const GUnit& u, int wr, int wc, int fr, int fq) const {
        const int pm = u.i0, pn = u.i1;
#pragma unroll
        for (int ai = 0; ai < 2; ++ai)
#pragma unroll
            for (int m = 0; m < 4; ++m) {
                const int r = pm * 256 + ai * 128 + wr * 64 + m * 16 + fr;
#pragma unroll
                for (int bj = 0; bj < 2; ++bj) {
                    const int c = pn * 256 + bj * 128 + wc * 32 + 8 * fq;
                    const u32x4 hv = __builtin_nontemporal_load((const u32x4*)(XN + (size_t)(256 + r) * DM + c)); const f32x4 a0 = acc[ai][bj][m][0], a1 = acc[ai][bj][m][1];
                    u32x4 w; w.x = pg8::cvt_pk_bf16(ALPHA * bflo(hv.x) + a0[0], ALPHA * bfhi(hv.x) + a0[1]); w.y = pg8::cvt_pk_bf16(ALPHA * bflo(hv.y) + a0[2], ALPHA * bfhi(hv.y) + a0[3]);
                    w.z = pg8::cvt_pk_bf16(ALPHA * bflo(hv.z) + a1[0], ALPHA * bfhi(hv.z) + a1[1]); w.w = pg8::cvt_pk_bf16(ALPHA * bflo(hv.w) + a1[2], ALPHA * bfhi(hv.w) + a1[3]);
                    *(u32x4*)(Z + (size_t)r * DM + c) = w;
                }
            }
    }
};
__device__ __forceinline__ void p4_outproj(Frame& F, const WaitMid mid) {
    DenseSched S; S.ord.init(MT / 256, 4, F.G, (int)blockIdx.x); S.A = (const char*)WSP(bf16, WS_ATT); S.Bt = (const char*)WSP(bf16, WS_WTOUT); S.lda = DM; S.K = DM; S.rowoff = 0; S.ldab = DM * 2;
    EpiOutProj E{WSP(bf16, WS_XN), WSP(bf16, WS_XN) + (size_t)256 * DM};
    pg8::gemm_phase<EpiOutProj, DenseSched, true, false, WaitMid>(F.lds, DM * 2, S, E, mid);
}
constexpr int MOE_TAB_OFF = 131072, EPI_TAB_OFF = 131072 + 1024;
template <bool GATHER> struct MoeSched {
    static constexpr int lda = DM, ldab = DM;
    const LAS int* ust; const LAS int* gs; int ncol, G, c; const char* A; const char* Bt; size_t estride; const int* rowtok;
    __device__ __forceinline__ bool next(int i, GUnit& u) const {
        const int L = i * G + c; if (L >= ust[32]) return false;
        const int ln_ = (int)(tidx() & 63u); const bool ge_ = (ln_ < 32) && (L >= ust[(ln_ & 31) + 1]);
        const int e = (int)__builtin_popcountll(__ballot(ge_));
        const int r = L - ust[e], rb = r / ncol, pn = r - rb * ncol;
        u.A = A; u.B = Bt + (size_t)e * estride + (size_t)pn * 256 * DM; u.i0 = e; u.i1 = pn; u.i4 = gs[e]; u.i2 = u.i4 + 256 * rb; u.i3 = gs[e + 1]; return true;
    }
    __device__ __forceinline__ int arow(const GUnit& u, int r) const { const int slot = u.i2 + r; return GATHER ? ((slot < u.i3) ? rowtok[(size_t)u.i0 * MT + (slot - u.i4)] : 0) : slot; }
    __device__ __forceinline__ int arow_next(const GUnit& u, int r, const LAS unsigned char* lds, int buf) const { return GATHER ? ((u.i2 + r < u.i3) ? ((const LAS int*)(lds + EPI_TAB_OFF + buf * 2048 + 1024))[r] : 0) : u.i2 + r; }
};
__device__ __forceinline__ void moe_tables(Frame& F, int ncol) {
    LAS int* ust = (LAS int*)(F.lds + MOE_TAB_OFF); LAS int* gs = ust + 64;
    __syncthreads();
    {   LAS int* gt = gs + 40;
        if (((int)tidx()) < 32) gt[((int)tidx())] = ((const int*)(F.ws + WS_CTL))[CW_GTOT + GTOT_STRIDE * ((int)tidx())];
        __syncthreads();
        if (((int)tidx()) < 32) { int run = 0;
#pragma unroll
            for (int i = 0; i < 31; ++i) run += (i < ((int)tidx())) ? gt[i] : 0;
            gs[((int)tidx())] = run; if (((int)tidx()) == 31) gs[32] = run + gt[31]; } }
    __syncthreads();
    if (((int)tidx()) < 32) { int run = 0;
#pragma unroll
        for (int i = 0; i < 31; ++i) run += (i < ((int)tidx())) ? ((gs[i + 1] - gs[i] + 255) >> 8) * ncol : 0;
        ust[((int)tidx())] = run;
        if (((int)tidx()) == 31) ust[32] = run + ((gs[32] - gs[31] + 255) >> 8) * ncol; }
    __syncthreads();
}
struct EpiMoeUp {
    static constexpr bool PERM = true, PREFETCH = true; const float* bg; const float* bu; unsigned char* A2; const int* rowtok;
    __device__ __forceinline__ void prefetch(LAS unsigned char* lds, const GUnit& u, int buf, int wid, int lane) const {
        const long off = (wid < 4) ? ((long)((wid >> 1) & 1) * (long)(bu - bg) + u.i0 * DM + u.i1 * 128 + (wid & 1) * 64) : ((long)((const float*)rowtok - bg) + (long)u.i0 * MT + (u.i2 - u.i4) + (wid - 4) * 64);
        __builtin_amdgcn_global_load_lds((const unsigned*)(bg + off + lane), (LAS unsigned*)(lds + EPI_TAB_OFF + buf * 2048 + wid * 256), 4, 0, 0);
    }
    __device__ __forceinline__ void operator()(const f32x4 (&acc)[2][2][4][2], const GUnit& u, int wr, int wc, int fr, int fq, LAS unsigned char* lds, int buf) const {
        const int pn = u.i1, s0 = u.i2, send = u.i3, colo = pn * 128 + wc * 32 + 8 * fq;
        const LAS float* tb_ = (const LAS float*)(lds + EPI_TAB_OFF + buf * 2048) + wc * 32 + 8 * fq;
        constexpr float NC = -2.4554669595930157f, IC = 1.0f / NC;
        f32x2 bgc[4], buc[4];
        {   const f32x4 g0 = *(const LAS f32x4*)tb_, g1 = *(const LAS f32x4*)(tb_ + 4), u0 = *(const LAS f32x4*)(tb_ + 128), u1 = *(const LAS f32x4*)(tb_ + 132);
            bgc[0] = (f32x2){g0.x, g0.y} * NC; bgc[1] = (f32x2){g0.z, g0.w} * NC; bgc[2] = (f32x2){g1.x, g1.y} * NC; bgc[3] = (f32x2){g1.z, g1.w} * NC;
            buc[0] = ((f32x2){u0.x, u0.y} + 1.0f) * IC; buc[1] = ((f32x2){u0.z, u0.w} + 1.0f) * IC; buc[2] = ((f32x2){u1.x, u1.y} + 1.0f) * IC; buc[3] = ((f32x2){u1.z, u1.w} + 1.0f) * IC; }
#pragma unroll
        for (int ai = 0; ai < 2; ++ai)
#pragma unroll
            for (int m = 0; m < 4; ++m) {
                const int slot = s0 + ai * 128 + wr * 64 + m * 16 + fr;
                if (slot < send) {
                    f32x2 a[4];
#pragma unroll
                    for (int q = 0; q < 4; ++q) {
                        const f32x4 gv = acc[ai][0][m][q >> 1], uv = acc[ai][1][m][q >> 1];
                        const f32x2 g2 = (q & 1) ? (f32x2){gv.z, gv.w} : (f32x2){gv.x, gv.y}, u2 = (q & 1) ? (f32x2){uv.z, uv.w} : (f32x2){uv.x, uv.y};
                        const f32x2 x = g2 * NC + bgc[q], uu = u2 * IC + buc[q];
                        const f32x2 mm = {fmaxf(x.x, 7.0f * NC), fmaxf(x.y, 7.0f * NC)};
                        const f32x2 d = (f32x2){__builtin_amdgcn_exp2f(mm.x), __builtin_amdgcn_exp2f(mm.y)} + 1.0f;
                        const f32x2 r = {__builtin_amdgcn_rcpf(d.x), __builtin_amdgcn_rcpf(d.y)};
                        const f32x2 w2 = {__builtin_amdgcn_fmed3f(uu.x, 8.0f * IC, -6.0f * IC), __builtin_amdgcn_fmed3f(uu.y, 8.0f * IC, -6.0f * IC)};
                        a[q] = (mm * w2) * r; }
                    u32x2 w; w.x = __builtin_amdgcn_cvt_pk_fp8_f32(a[0].x, a[0].y, 0, false); w.x = __builtin_amdgcn_cvt_pk_fp8_f32(a[1].x, a[1].y, w.x, true);
                    w.y = __builtin_amdgcn_cvt_pk_fp8_f32(a[2].x, a[2].y, 0, false); w.y = __builtin_amdgcn_cvt_pk_fp8_f32(a[3].x, a[3].y, w.y, true);
                    *(u32x2*)(A2 + (size_t)slot * DM + colo) = w;
                }
            }
    }
};
__device__ __forceinline__ void p7_moe_up(Frame& F) {
    moe_tables(F, 8);
    MoeSched<true> S{(const LAS int*)(F.lds + MOE_TAB_OFF), (const LAS int*)(F.lds + MOE_TAB_OFF) + 64, 8, F.G, F.vcu, (const char*)(F.ws + WS_H1Q), (const char*)(F.ws + WS_X), (size_t)2048 * DM, WSP(int, WS_RT2)};
    EpiMoeUp E{F.in[I_BGATE], F.in[I_BUP], (unsigned char*)(F.ws + WS_A2), WSP(int, WS_RT2)};
    pg8::gemm_phase<EpiMoeUp, MoeSched<true>, true, true>(F.lds, DM, S, E);
}
constexpr float YSCALE = 16.0f;
struct EpiMoeDown {
    static constexpr bool PERM = true, PREFETCH = true; const float* bd; const int* slotdst; unsigned char* Y;
    __device__ __forceinline__ void prefetch(LAS unsigned char* lds, const GUnit& u, int buf, int wid, int lane) const {
        const long off = (wid < 4) ? ((long)u.i0 * MT + (u.i2 - u.i4) + wid * 64) : ((long)((const unsigned*)bd - (const unsigned*)slotdst) + u.i0 * DM + u.i1 * 256 + (wid - 4) * 64);
        const unsigned* src = (const unsigned*)slotdst + off + lane;
        __builtin_amdgcn_global_load_lds(src, (LAS unsigned*)(lds + EPI_TAB_OFF + buf * 2048 + wid * 256), 4, 0, 0);
    }
    __device__ __forceinline__ void operator()(const f32x4 (&acc)[2][2][4][2], const GUnit& u, int wr, int wc, int fr, int fq, LAS unsigned char* lds, int buf) const {
        const int pn = u.i1, s0 = u.i2, send = u.i3;
        const LAS int* tS = (const LAS int*)(lds + EPI_TAB_OFF + buf * 2048); const LAS float* tB = (const LAS float*)(lds + EPI_TAB_OFF + buf * 2048 + 1024);
        int dsts[2][4];
#pragma unroll
        for (int ai = 0; ai < 2; ++ai)
#pragma unroll
            for (int m = 0; m < 4; ++m) { const int slot = s0 + ai * 128 + wr * 64 + m * 16 + fr; dsts[ai][m] = (slot < send) ? tS[ai * 128 + wr * 64 + m * 16 + fr] : -1; }
        f32x4 bv[2][2];
#pragma unroll
        for (int bj = 0; bj < 2; ++bj) { const int c = bj * 128 + wc * 32 + 8 * fq; bv[bj][0] = *(const LAS f32x4*)(tB + c) * YSCALE; bv[bj][1] = *(const LAS f32x4*)(tB + c + 4) * YSCALE; }
#pragma unroll
        for (int ai = 0; ai < 2; ++ai)
#pragma unroll
            for (int m = 0; m < 4; ++m) {
                u32x2 w[2];
#pragma unroll
                for (int bj = 0; bj < 2; ++bj) {
                    const f32x4 v0 = acc[ai][bj][m][0] * YSCALE + bv[bj][0], v1 = acc[ai][bj][m][1] * YSCALE + bv[bj][1];
                    w[bj].x = __builtin_amdgcn_cvt_pk_fp8_f32(v0[0], v0[1], 0, false); w[bj].x = __builtin_amdgcn_cvt_pk_fp8_f32(v0[2], v0[3], w[bj].x, true);
                    w[bj].y = __builtin_amdgcn_cvt_pk_fp8_f32(v1[0], v1[1], 0, false); w[bj].y = __builtin_amdgcn_cvt_pk_fp8_f32(v1[2], v1[3], w[bj].y, true); }
                const auto rx = __builtin_amdgcn_permlane16_swap(w[0].x, w[1].x, false, false); const auto ry = __builtin_amdgcn_permlane16_swap(w[0].y, w[1].y, false, false);
                const int d = dsts[ai][m];
                if (d >= 0) {
                    const int c = pn * 256 + wc * 32 + ((fq & 1) ? 128 + 8 * (fq - 1) : 8 * fq);
                    u32x4 o; o.x = rx[0]; o.y = ry[0]; o.z = rx[1]; o.w = ry[1];
                    *(u32x4*)(Y + (size_t)d * DM + c) = o;
                }
            }
    }
};
__device__ __forceinline__ void p8_moe_down(Frame& F, const WaitMid mid) {
    MoeSched<false> S{(const LAS int*)(F.lds + MOE_TAB_OFF), (const LAS int*)(F.lds + MOE_TAB_OFF) + 64, 4, F.G, F.vcu, (const char*)(F.ws + WS_A2), (const char*)(F.ws + WS_WD), (size_t)DM * DM, nullptr};
    EpiMoeDown E{F.in[I_BDOWN], WSP(int, WS_SD2), (unsigned char*)F.out};
    pg8::gemm_phase<EpiMoeDown, MoeSched<false>, true, true, WaitMid>(F.lds, DM, S, E, mid);
}


namespace attn {
typedef short bf16x8 __attribute__((ext_vector_type(8)));
typedef short s16x4 __attribute__((ext_vector_type(4)));
typedef short v4i16_t __attribute__((ext_vector_type(4)));
typedef float f32x16 __attribute__((ext_vector_type(16)));
constexpr int SLOTB = 16384, NKS = 3, NVS = 4;
constexpr int LDS_K = 0, LDS_V = NKS * SLOTB, LDS_WS = (NKS + NVS) * SLOTB, LDS_LUT = 131072 + 10240, LDS_SG = LDS_LUT + 1024, LDS_END = LDS_WS + 8 * 64 * 4;
constexpr int XROW = 132;
__device__ __forceinline__ int crow(int r, int hi) { return (r & 3) + 8 * (r >> 2) + 4 * hi; }
__device__ __forceinline__ void glds16(const void* gsrc, unsigned lds_dst) { unsigned keep;
    asm volatile("s_mov_b32 %0, m0\n\ts_mov_b32 m0, %2\n\ts_nop 0\n\tglobal_load_lds_dwordx4 %1, off\n\ts_mov_b32 m0, %0" : "=&s"(keep) : "v"(gsrc), "s"(lds_dst) : "memory"); }
__device__ __forceinline__ float max3f(float a, float b, float c) { return __builtin_fmaxf(__builtin_fmaxf(a, b), c); }
typedef float f32x2_t __attribute__((ext_vector_type(2))); typedef __bf16 bf16x2_t __attribute__((ext_vector_type(2)));
__device__ __forceinline__ unsigned cvtpk_s(float lo, float hi) { f32x2_t v = {lo, hi}; bf16x2_t b = __builtin_convertvector(v, bf16x2_t); return __builtin_bit_cast(unsigned, b); }
#define AWAIT_BAR(N) asm volatile("s_waitcnt vmcnt(" #N ") lgkmcnt(0)\n\ts_barrier" ::: "memory")
__device__ __forceinline__ s16x4 vtr(const LAS unsigned char* p) { return __builtin_bit_cast(s16x4, __builtin_amdgcn_ds_read_tr16_b64_v4i16((LAS v4i16_t*)p)); }
typedef int v8i_t __attribute__((ext_vector_type(8))); typedef int v2i_t __attribute__((ext_vector_type(2))); typedef int v4i_q __attribute__((ext_vector_type(4)));
__device__ __forceinline__ void qkt(f32x16& p0, f32x16& p1, const LAS unsigned char* Kslot, const v8i_t& qf, const f32x16& cinit, int r32, int hi) {
    const LAS unsigned char* kb = Kslot + hi * 2048 + r32 * 16;
    const v4i_q a0 = *(const LAS v4i_q*)(kb), a1 = *(const LAS v4i_q*)(kb + 1024), b0 = *(const LAS v4i_q*)(kb + 512), b1 = *(const LAS v4i_q*)(kb + 1024 + 512);
    const v8i_t k0 = __builtin_shufflevector(a0, a1, 0, 1, 2, 3, 4, 5, 6, 7), k1 = __builtin_shufflevector(b0, b1, 0, 1, 2, 3, 4, 5, 6, 7);
    p0 = __builtin_amdgcn_mfma_scale_f32_32x32x64_f8f6f4(k0, qf, cinit, 0, 0, 0, 122, 0, 127);
    p1 = __builtin_amdgcn_mfma_scale_f32_32x32x64_f8f6f4(k1, qf, cinit, 0, 0, 0, 122, 0, 127);
}
__device__ __forceinline__ float rowmax(const f32x16& p0, const f32x16& p1) {
    float a = max3f(p0[0], p0[1], p1[0]), b = max3f(p0[2], p0[3], p1[1]); a = max3f(a, p1[2], p1[3]);
#pragma unroll
    for (int r = 4; r < 16; r += 4) { a = max3f(a, p0[r], p0[r + 1]); b = max3f(b, p0[r + 2], p0[r + 3]); a = max3f(a, p1[r], p1[r + 1]); b = max3f(b, p1[r + 2], p1[r + 3]); }
    const float m = fmaxf(a, b);
    auto rr = __builtin_amdgcn_permlane32_swap(__float_as_uint(m), __float_as_uint(m), false, false);
    return fmaxf(__uint_as_float(rr[0]), __uint_as_float(rr[1]));
}
__device__ __forceinline__ void pv_ks(f32x16* o, const LAS unsigned char* vp, int ks, bf16x8 pa) {
#pragma unroll
    for (int d0 = 0; d0 < 4; ++d0) { const s16x4 lo = vtr(vp + d0 * 4096 + ks * 1024), hi = vtr(vp + d0 * 4096 + ks * 1024 + 512);
        o[d0] = __builtin_amdgcn_mfma_f32_32x32x16_bf16(pa, (bf16x8){lo[0], lo[1], lo[2], lo[3], hi[0], hi[1], hi[2], hi[3]}, o[d0], 0, 0, 0); }
}
struct WaveState { float mhat, l_reg; f32x16 o[4]; };
#define ASB() __builtin_amdgcn_sched_barrier(0)
template <int THR>
__device__ __forceinline__ bool scores(f32x16& p0, f32x16& p1, WaveState& W, int t, int qrow0, const LAS unsigned char* Kslot, const v8i_t& qr, float c15, const LAS float* LUT, LAS float* wsf, int r32, int hi) {
    const int kmax = (t == 0) ? -1 : (64 * (t - 1) + 63);
    const bool near = (t == 0) ? (qrow0 < 90) : (kmax - qrow0 > -91);
    f32x16 cin; { const float cv = (near ? 0.f : c15) - W.mhat;
#pragma unroll
        for (int r = 0; r < 16; ++r) cin[r] = cv; }
    qkt(p0, p1, Kslot, qr, cin, r32, hi);
    if (near) {
        const int relb0 = ((t == 0) ? -16 : 64 * (t - 1)) - qrow0 - r32 + 128;
#pragma unroll
        for (int r = 0; r < 16; ++r) { int i0 = relb0 + crow(r, hi); int i1 = i0 + 32; i0 = i0 < 0 ? 0 : i0; i1 = i1 < 0 ? 0 : i1; i1 = i1 > 191 ? 191 : i1; p0[r] += LUT[i0]; p1[r] += LUT[i1]; }
    }
    if (t == 0) {
#pragma unroll
        for (int r = 0; r < 16; ++r) { if (r >= 8) p0[r] = -INFINITY; p1[r] = -INFINITY; }
    }
    const float rm = rowmax(p0, p1);
    bool resc = false;
    if (t == 0 || __any(rm > 8.5f)) {
        const float dl = (t == 0) ? rm - 7.0f : fmaxf(rm - 7.0f, 0.f); W.mhat += dl;
#pragma unroll
        for (int r = 0; r < 16; ++r) { p0[r] -= dl; p1[r] -= dl; }
        const float f = __builtin_amdgcn_exp2f(-dl); W.l_reg *= f;
        if (t != 0) { if (hi == 0) wsf[r32] = f; resc = true; }
    }
    return resc;
}
__device__ __forceinline__ bf16x8 expack(const f32x16& p, int base, float& sacc) {
    float e[8];
#pragma unroll
    for (int j = 0; j < 8; ++j) { e[j] = __builtin_amdgcn_exp2f(p[base + j]); }
    sacc += ((e[0] + e[1]) + (e[2] + e[3])) + ((e[4] + e[5]) + (e[6] + e[7]));
    u32x4 w = (u32x4){cvtpk_s(e[0], e[1]), cvtpk_s(e[2], e[3]), cvtpk_s(e[4], e[5]), cvtpk_s(e[6], e[7])};
    return __builtin_bit_cast(bf16x8, w);
}
__device__ __forceinline__ v8i_t vload8(const LAS unsigned char* vp, int d0) {
    const v2i_t r0 = __builtin_amdgcn_ds_read_tr8_b64_v2i32((LAS v2i_t*)(vp + d0 * 2048)), r1 = __builtin_amdgcn_ds_read_tr8_b64_v2i32((LAS v2i_t*)(vp + d0 * 2048 + 256));
    const v2i_t r2 = __builtin_amdgcn_ds_read_tr8_b64_v2i32((LAS v2i_t*)(vp + d0 * 2048 + 512)), r3 = __builtin_amdgcn_ds_read_tr8_b64_v2i32((LAS v2i_t*)(vp + d0 * 2048 + 768));
    return (v8i_t){r0.x, r0.y, r1.x, r1.y, r2.x, r2.y, r3.x, r3.y}; }
__device__ __forceinline__ void pvmm8(f32x16& o, const v8i_t& pa, const v8i_t& vb, int sc) {
    asm volatile("s_nop 1\n\tv_mfma_scale_f32_32x32x64_f8f6f4 %0, %1, %2, %0, %3, %3 op_sel_hi:[0,0,0]" : "+v"(o) : "v"(pa), "v"(vb), "v"(sc)); }
__device__ __forceinline__ void expack8(const f32x16& p, int base, float& sacc, int& w0, int& w1) {
    float e[8];
#pragma unroll
    for (int j = 0; j < 8; ++j) { float x = p[base + j]; asm volatile("" : "+v"(x)); e[j] = __builtin_amdgcn_exp2f(x); }
    sacc += ((e[0] + e[1]) + (e[2] + e[3])) + ((e[4] + e[5]) + (e[6] + e[7]));
    int a = __builtin_amdgcn_cvt_pk_fp8_f32(e[0], e[1], __builtin_bit_cast(int, e[0]), false); a = __builtin_amdgcn_cvt_pk_fp8_f32(e[2], e[3], a, true);
    int c = __builtin_amdgcn_cvt_pk_fp8_f32(e[4], e[5], __builtin_bit_cast(int, e[4]), false); c = __builtin_amdgcn_cvt_pk_fp8_f32(e[6], e[7], c, true);
    w0 = a; w1 = c; }
struct VF { s16x4 v[8]; };
__device__ __forceinline__ VF vload(const LAS unsigned char* vp, int ks) { VF f;
#pragma unroll
    for (int d0 = 0; d0 < 4; ++d0) { f.v[2 * d0] = vtr(vp + d0 * 4096 + ks * 1024); f.v[2 * d0 + 1] = vtr(vp + d0 * 4096 + ks * 1024 + 512); }
    return f; }
__device__ __forceinline__ void pvmm(f32x16* o, bf16x8 pa, const VF& f) {
#pragma unroll
    for (int d0 = 0; d0 < 4; ++d0) o[d0] = __builtin_amdgcn_mfma_f32_32x32x16_bf16(pa, (bf16x8){f.v[2 * d0][0], f.v[2 * d0][1], f.v[2 * d0][2], f.v[2 * d0][3], f.v[2 * d0 + 1][0], f.v[2 * d0 + 1][1], f.v[2 * d0 + 1][2], f.v[2 * d0 + 1][3]}, o[d0], 0, 0, 0);
}
template <int THR>
__device__ __forceinline__ void attn_unit(int b, int h, int qb, const unsigned char* Qg, const unsigned char* Kg, const unsigned char* Vg, bf16* ATT, float c15, float lam, LAS unsigned char* lds) {
    int tid_ = (int)tidx();
    const int tid = tid_, lane = tid & 63, r32 = lane & 31, hi = lane >> 5; const int wid = __builtin_amdgcn_readfirstlane(tid >> 6), rg = wid & 3, m = wid >> 2;
    const unsigned lds0 = (unsigned)(uintptr_t)lds;
    LAS float* wsf = (LAS float*)(lds + LDS_WS) + wid * 64;
    LAS float* LUT = (LAS float*)(lds + LDS_LUT);
    const int qrow0 = qb * 128 + rg * 32;
    const int NT = 2 * qb + 3, tvis = 1 + 2 * qb + (rg >> 1);
    const size_t rowb = (size_t)256 + (size_t)b * SEQ;
    const unsigned char* ksrc = Kg + (size_t)lane * QW + h * 128 + (wid >> 2) * 64 + (wid & 3) * 16;
    const int vj = lane >> 1, vkey = ((vj & 3) + 8 * ((vj & 15) >> 2) + 4 * (wid & 1)) + 32 * (vj >> 4);
    const unsigned char* vsrc = Vg + (size_t)vkey * QW + h * 128 + 32 * (wid >> 1) + 16 * (lane & 1);
    const unsigned kdst = lds0 + LDS_K + wid * 1024, vdst = lds0 + LDS_V + wid * 1024;
#define ADMA(t, ks_, vs_) do { const size_t ro_ = ((t) == 0) ? (size_t)0 : (rowb + (size_t)64 * ((t) - 1)); const unsigned ko_ = (unsigned)(ks_) * SLOTB, vo_ = (unsigned)(vs_) * SLOTB; \
        glds16(ksrc + ro_ * QW, (unsigned)__builtin_amdgcn_readfirstlane(kdst + ko_)); \
        glds16(vsrc + ro_ * QW, (unsigned)__builtin_amdgcn_readfirstlane(vdst + vo_)); } while (0)
    ADMA(0, 0, 0); ADMA(1, 1, 1);
    v8i_t qr;
    { const unsigned char* Qw = Qg + (rowb + qrow0 + r32) * QW + h * 128 + m * 64 + hi * 32;
      const v4i_q q0 = *(const v4i_q*)Qw, q1 = *(const v4i_q*)(Qw + 16); qr = __builtin_shufflevector(q0, q1, 0, 1, 2, 3, 4, 5, 6, 7); }
    WaveState W; W.mhat = 0.f; W.l_reg = 0.f;
#pragma unroll
    for (int d0 = 0; d0 < 4; ++d0) W.o[d0] = f32x16{};
    const LAS unsigned char* vp0 = lds + LDS_V + hi * 1024 + ((lane & 15) >> 1) * 32 + ((lane >> 4) & 1) * 16 + (lane & 1) * 8;
    const LAS unsigned char* kp0 = lds + LDS_K + m * 4096;
    int kslot = 0, vslot = 0, pvslot = 0; bool pend = false;
    v8i_t pa = {}; const int sc1 = 127;
    {   AWAIT_BAR(2); ADMA(2, 2 % NKS, 2 % NVS);
        f32x16 p0, p1; (void)scores<THR>(p0, p1, W, 0, qrow0, kp0, qr, c15, LUT, wsf, r32, hi);
        float sacc = 0.f; int pw[8];
        expack8(p0, 0, sacc, pw[0], pw[1]); expack8(p0, 8, sacc, pw[2], pw[3]); expack8(p1, 0, sacc, pw[4], pw[5]); expack8(p1, 8, sacc, pw[6], pw[7]);
        pa = (v8i_t){pw[0], pw[1], pw[2], pw[3], pw[4], pw[5], pw[6], pw[7]};
        W.l_reg += sacc; pend = true; pvslot = 0; kslot = 1; vslot = 1; }
    for (int t = 1; t < NT; ++t) {
        __builtin_assume(t > 0);
        if (t + 1 < NT) { AWAIT_BAR(2); } else { AWAIT_BAR(0); }
        if (t + 2 < NT) { ADMA(t + 2, (kslot + 2) % NKS, (vslot + 2) % NVS); }
        const bool vis = t <= tvis; const LAS unsigned char* vp = vp0 + pvslot * SLOTB;
        if (vis) {
            f32x16 p0, p1;
            const bool resc = scores<THR>(p0, p1, W, t, qrow0, kp0 + kslot * SLOTB, qr, c15, LUT, wsf, r32, hi);
            float sacc = 0.f;
            int pw[8];
            {   const v8i_t b0 = vload8(vp, 0), b1 = vload8(vp, 1); ASB();
                pvmm8(W.o[0], pa, b0, sc1); expack8(p0, 0, sacc, pw[0], pw[1]); const v8i_t b2 = vload8(vp, 2); ASB();
                pvmm8(W.o[1], pa, b1, sc1); expack8(p0, 8, sacc, pw[2], pw[3]); const v8i_t b3 = vload8(vp, 3); ASB();
                pvmm8(W.o[2], pa, b2, sc1); expack8(p1, 0, sacc, pw[4], pw[5]); ASB();
                pvmm8(W.o[3], pa, b3, sc1); expack8(p1, 8, sacc, pw[6], pw[7]); ASB(); }
            pa = (v8i_t){pw[0], pw[1], pw[2], pw[3], pw[4], pw[5], pw[6], pw[7]};
            if (resc) {
                asm volatile("s_waitcnt lgkmcnt(0)\n\ts_nop 15\n\ts_nop 15\n\ts_nop 7" ::: "memory");
#pragma unroll
                for (int r = 0; r < 16; ++r) { const float fr = wsf[crow(r, hi)];
#pragma unroll
                    for (int d0 = 0; d0 < 4; ++d0) { float x = W.o[d0][r]; asm volatile("v_mul_f32 %0, %0, %1" : "+v"(x) : "v"(fr)); W.o[d0][r] = x; } }
                asm volatile("s_waitcnt lgkmcnt(0)" ::: "memory");
            }
            W.l_reg += sacc; pend = true; pvslot = vslot;
        } else if (pend) {
            const v8i_t b0 = vload8(vp, 0), b1 = vload8(vp, 1); ASB();
            pvmm8(W.o[0], pa, b0, sc1); const v8i_t b2 = vload8(vp, 2); ASB();
            pvmm8(W.o[1], pa, b1, sc1); const v8i_t b3 = vload8(vp, 3); ASB();
            pvmm8(W.o[2], pa, b2, sc1); pvmm8(W.o[3], pa, b3, sc1);
            asm volatile("s_nop 15\n\ts_nop 15" ::: "memory"); ASB();
            pend = false;
        }
        kslot = (kslot == NKS - 1) ? 0 : kslot + 1; vslot = (vslot == NVS - 1) ? 0 : vslot + 1;
    }
    if (pend) { const LAS unsigned char* vp = vp0 + pvslot * SLOTB;
        const v8i_t b0 = vload8(vp, 0), b1 = vload8(vp, 1); ASB();
        pvmm8(W.o[0], pa, b0, sc1); const v8i_t b2 = vload8(vp, 2); ASB();
        pvmm8(W.o[1], pa, b1, sc1); const v8i_t b3 = vload8(vp, 3); ASB();
        pvmm8(W.o[2], pa, b2, sc1); pvmm8(W.o[3], pa, b3, sc1); }
    asm volatile("s_nop 15\n\ts_nop 15\n\ts_nop 7" ::: "memory"); ASB();
    float l_reg = W.l_reg;
    { auto rr = __builtin_amdgcn_permlane32_swap(__float_as_uint(l_reg), __float_as_uint(l_reg), false, false); l_reg = __uint_as_float(rr[0]) + __uint_as_float(rr[1]); }
    if (hi == 0) wsf[32 + r32] = l_reg;
    asm volatile("s_waitcnt lgkmcnt(0)" ::: "memory");
    float rli[16];
#pragma unroll
    for (int r = 0; r < 16; ++r) rli[r] = __builtin_amdgcn_rcpf(wsf[32 + crow(r, hi)]) * (1.0f / VSCALE);
    AWAIT_BAR(0);
    LAS float* X = (LAS float*)lds + rg * (32 * XROW);
    if (m == 1) {
#pragma unroll
        for (int r = 0; r < 16; ++r) { const float sc = rli[r] * lam;
#pragma unroll
            for (int d0 = 0; d0 < 4; ++d0) X[crow(r, hi) * XROW + 32 * d0 + r32] = W.o[d0][r] * sc; }
    }
    AWAIT_BAR(0);
    if (m == 0) {
#pragma unroll
        for (int r = 0; r < 16; ++r) {
#pragma unroll
            for (int d0 = 0; d0 < 4; ++d0) { LAS float* xp = X + crow(r, hi) * XROW + 32 * d0 + r32; *xp = W.o[d0][r] * rli[r] - *xp; } }
        asm volatile("s_waitcnt lgkmcnt(0)" ::: "memory");
        const int row = lane >> 1, half = lane & 1; const LAS float* xr = X + row * XROW + half * 64;
        f32x4 v[16]; float ss = 0.f;
#pragma unroll
        for (int i = 0; i < 16; ++i) { v[i] = *(const LAS f32x4*)(xr + 4 * i); ss += (v[i].x * v[i].x + v[i].y * v[i].y) + (v[i].z * v[i].z + v[i].w * v[i].w); }
        ss += __shfl_xor(ss, 1);
        const float rn = rsqrtf(ss * (1.0f / 128.0f) + LN_EPS) * 0.8f;
        bf16* dst = ATT + (size_t)(b * SEQ + qb * 128 + rg * 32 + row) * DM + h * 128 + half * 64;
#pragma unroll
        for (int i = 0; i < 8; ++i) { const LAS float* sg_ = (const LAS float*)(lds + LDS_SG) + half * 64 + 8 * i; const f32x4 g0 = *(const LAS f32x4*)sg_, g1 = *(const LAS f32x4*)(sg_ + 4); const f32x4 a = v[2 * i] * rn * g0, c = v[2 * i + 1] * rn * g1;
            u32x4 w; w.x = cvtpk_s(a.x, a.y); w.y = cvtpk_s(a.z, a.w); w.z = cvtpk_s(c.x, c.y); w.w = cvtpk_s(c.z, c.w); *(u32x4*)(dst + 8 * i) = w; }
    }
    AWAIT_BAR(0);
#undef ADMA
}
}
__device__ __forceinline__ void p6_attention_unit(Frame& F, int i) {
    const int bh = F.vcu >> 5, sidx = F.vcu & 31;
    constexpr int R = 128 - 4 * ATT_NA;
    int nu = 1, q0 = (i == 0) ? 127 - sidx : (i == 1) ? 128 - 2 * ATT_NA + sidx : (i == 2) ? 127 - 2 * ATT_NA - sidx : R + sidx, qs = 0;
    if (sidx >= ATT_NA) {
        constexpr int NJ = 96 * 256 / ATT_NTW, J1 = NJ * 42 / 100, J2 = NJ * 73 / 100, J3 = NJ * 92 / 100;
        const int j0 = (i == 0) ? 0 : (i == 1) ? J1 : (i == 2) ? J2 : J3, j1 = (i == 0) ? J1 : (i == 1) ? J2 : (i == 2) ? J3 : NJ;
        p0_expert_stream(F, (bh * ATT_NT + (sidx - ATT_NA)) * 8 + F.wave, j0, j1);
        if (i != 3) return;
        nu = R / ATT_NT; q0 = sidx - ATT_NA; qs = ATT_NT;
    }
    const float lam = WSP(float, WS_PAR)[PF_LAM];
    const float c15 = F.in[I_RELB][15 * NH + (bh & 3)] * LOG2E;
    __syncthreads();
    if (i == 0 || sidx >= ATT_NA) {
        LAS float* LUT = (LAS float*)(F.lds + attn::LDS_LUT); const int tq = (int)tidx();
        if (tq < 192) LUT[tq] = F.in[I_RELB][t5_bucket(tq - 128) * NH + (bh & 3)] * LOG2E;
        else if (tq < 320) ((LAS float*)(F.lds + attn::LDS_SG))[tq - 192] = F.in[I_SUBLN][tq - 192];
        __syncthreads(); }
#pragma nounroll
    for (int u = 0; u < nu; ++u) {
        const int qb = q0 + qs * u;
        attn::attn_unit<8>(bh >> 2, bh & 3, qb, (const unsigned char*)(F.ws + WS_Q), (const unsigned char*)(F.ws + WS_K), (const unsigned char*)(F.ws + WS_V), WSP(bf16, WS_ATT), c15, lam, F.lds);
    }
}

__device__ __forceinline__ void reduce_scatter32(float (&p)[32], int lane) {
#pragma unroll
    for (int i = 0; i < 16; ++i) { auto r = __builtin_amdgcn_permlane32_swap(__float_as_uint(p[i]), __float_as_uint(p[i + 16]), false, false); p[i] = __uint_as_float(r[0]) + __uint_as_float(r[1]); }
#pragma unroll
    for (int i = 0; i < 8; ++i) { auto r = __builtin_amdgcn_permlane16_swap(__float_as_uint(p[i]), __float_as_uint(p[i + 8]), false, false); p[i] = __uint_as_float(r[0]) + __uint_as_float(r[1]); }
    { const bool up = (lane & 8) != 0;
#pragma unroll
      for (int i = 0; i < 4; ++i) { const float keep = up ? p[i + 4] : p[i], send = up ? p[i] : p[i + 4]; p[i] = keep + dpp_f<DPP_ROR8>(send); } }
    { const bool up = (lane & 4) != 0;
#pragma unroll
      for (int i = 0; i < 2; ++i) { const float keep = up ? p[i + 2] : p[i], send = up ? p[i] : p[i + 2]; p[i] = keep + dpp_f<DPP_HMIRROR>(send); } }
    { const bool up = (lane & 2) != 0; const float keep = up ? p[1] : p[0], send = up ? p[0] : p[1]; p[0] = keep + dpp_f<DPP_XOR2>(send); }
}
struct SsmSched {
    static constexpr int lda = AK, ldab = AK * 2;
    int G, c, K; const char* AS; const char* Bt;
    __device__ __forceinline__ bool next(int i, GUnit& u) const { const int L = i * G + c; if (L >= 256) return false; const int g = L >> 3, pm = L & 7;
        u.A = AS + (size_t)g * CHR * AK * 2; u.B = Bt + (size_t)g * 256 * K * 2; u.i0 = g; u.i1 = pm; u.i2 = 0; u.i3 = 0; u.i4 = 0; return true; }
    __device__ __forceinline__ int arow(const GUnit& u, int r) const { return u.i1 * 256 + r; }
    __device__ __forceinline__ int arow_next(const GUnit& u, int r, const LAS unsigned char*, int) const { return arow(u, r); }
};
struct EpiSsmE {
    static constexpr bool PERM = false; static constexpr bool PREFETCH = false; float* E;
    __device__ __forceinline__ void operator()(const f32x4 (&acc)[2][2][4][2], const GUnit& u, int wr, int wc, int fr, int fq) const {
        const int g = u.i0, pm = u.i1;
#pragma unroll
        for (int ai = 0; ai < 2; ++ai)
#pragma unroll
            for (int m = 0; m < 4; ++m) { const int ch = pm * 256 + ai * 128 + wr * 64 + m * 16 + fr;
#pragma unroll
                for (int n = 0; n < 2; ++n) *(f32x4*)(E + ((size_t)g * NCH + ch) * 128 + wc * 32 + 16 * n + 4 * fq) = acc[ai][0][m][n]; }
    }
};
__device__ __forceinline__ float ld_sc1(const float* p) { return __uint_as_float(__hip_atomic_load((const unsigned*)p, __ATOMIC_RELAXED, __HIP_MEMORY_SCOPE_AGENT)); }
__device__ __forceinline__ void ps1_ssm_e(Frame& F, const WaitMid mid) {
    SsmSched S{F.G, F.vcu, 256, (const char*)WSP(bf16, WS_ASSM), (const char*)WSP(bf16, WS_BTE)};
    float* E = (float*)((unsigned char*)F.out + DO_E); float* BE = (float*)((unsigned char*)F.out + DO_BE); float* PAR = WSP(float, WS_PAR);
    EpiSsmE Ep{E};
    pg8::gemm_phase<EpiSsmE, SsmSched, true, false, WaitMid>(F.lds, 256 * 2, S, Ep, mid);
    if (F.vcu >= 256) return;
    asm volatile("s_waitcnt vmcnt(0)" ::: "memory"); __syncthreads();
    const int g = F.vcu >> 3, pm = F.vcu & 7, n = ((int)tidx()) & 63, q = ((int)tidx()) >> 6;
    const float a16r = PAR[PF_A16 + (g * 64 + n) * 2], a16i = PAR[PF_A16 + (g * 64 + n) * 2 + 1];
#pragma unroll
    for (int bq = 0; bq < 2; ++bq) {
        const int bl = q + 8 * bq; const float* ep = E + ((size_t)g * NCH + pm * 256 + bl * 16) * 128 + n;
        float er[16], ei[16];
#pragma unroll
        for (int i = 0; i < 16; ++i) { er[i] = ld_sc1(ep + i * 128); ei[i] = ld_sc1(ep + i * 128 + 64); }
        float sr = 0.f, si = 0.f;
#pragma unroll
        for (int i = 0; i < 16; ++i) { const float nr = a16r * sr - a16i * si + er[i], ni = a16r * si + a16i * sr + ei[i]; sr = nr; si = ni; }
        BE[((size_t)g * 128 + pm * 16 + bl) * 128 + n] = sr; BE[((size_t)g * 128 + pm * 16 + bl) * 128 + 64 + n] = si;
    }
    if (pm == 0 && ((int)tidx()) < 128) {
        const bf16* up = WSP(bf16, WS_ASSM) + ((size_t)g * CHR + NCH) * AK; const bf16* wp = WSP(bf16, WS_BTE) + ((size_t)g * 256 + ((int)tidx())) * 256; float acc = 0.f;
        for (int k = 0; k < 256; k += 8) { const u32x4 a = *(const u32x4*)(up + k), w = *(const u32x4*)(wp + k);
            acc += bflo(a.x) * bflo(w.x) + bfhi(a.x) * bfhi(w.x) + bflo(a.y) * bflo(w.y) + bfhi(a.y) * bfhi(w.y) + bflo(a.z) * bflo(w.z) + bfhi(a.z) * bfhi(w.z) + bflo(a.w) * bflo(w.w) + bfhi(a.w) * bfhi(w.w); }
        PAR[PF_SM + (g * 64 + (((int)tidx()) & 63)) * 2 + (((int)tidx()) >> 6)] = acc;
    }
}
__device__ __forceinline__ void ps2_ssm_carry(Frame& F) {
    const int gw = F.vcu * 8 + F.wave; if (gw >= 2048) return;
    const int b = gw >> 10, g = (gw >> 5) & 31, s = gw & 31, n = ((int)(tidx() & 63u)), gn = g * 64 + n;
    const float* PAR = WSP(float, WS_PAR); const float* E = (const float*)((const unsigned char*)F.out + DO_E); const float* BE = (const float*)((const unsigned char*)F.out + DO_BE);
    bf16* AS = WSP(bf16, WS_ASSM) + (size_t)g * CHR * AK;
    const float a16r = PAR[PF_A16 + gn * 2], a16i = PAR[PF_A16 + gn * 2 + 1], a256r = PAR[PF_A256 + gn * 2], a256i = PAR[PF_A256 + gn * 2 + 1];
    float cr = PAR[PF_SM + gn * 2], ci = PAR[PF_SM + gn * 2 + 1];
    const float* bep = BE + ((size_t)g * 128 + b * 64) * 128 + n;
    int bb = 0;
#pragma unroll
    for (int pass = 0; pass < 2; ++pass) {
        const int blk = pass == 0 ? s : 63 - s;
#pragma unroll 4
        for (; bb < blk; ++bb) { const float er = bep[bb * 128], ei = bep[bb * 128 + 64]; const float nr = a256r * cr - a256i * ci + er, ni = a256r * ci + a256i * cr + ei; cr = nr; ci = ni; }
        const int ch0 = b * 1024 + blk * 16; const float* ep = E + ((size_t)g * NCH + ch0) * 128 + n;
        float er[16], ei[16];
#pragma unroll
        for (int i = 0; i < 16; ++i) { er[i] = ep[i * 128]; ei[i] = ep[i * 128 + 64]; }
        float sr = cr, si = ci;
#pragma unroll
        for (int i = 0; i < 16; ++i) {
            bf16* dst = AS + (size_t)(ch0 + i) * AK + 256 + n; dst[0] = (bf16)f2bf(sr); dst[64] = (bf16)f2bf(si);
            const float nr = a16r * sr - a16i * si + er[i], ni = a16r * si + a16i * sr + ei[i]; sr = nr; si = ni; }
    }
}
struct EpiSsmY {
    static constexpr bool PERM = true; static constexpr bool PREFETCH = false; bf16* Gb;
    __device__ __forceinline__ void operator()(const f32x4 (&acc)[2][2][4][2], const GUnit& u, int wr, int wc, int fr, int fq) const {
        const int g = u.i0, pm = u.i1;
#pragma unroll
        for (int ai = 0; ai < 2; ++ai)
#pragma unroll
            for (int m = 0; m < 4; ++m) { const int ch = pm * 256 + ai * 128 + wr * 64 + m * 16 + fr;
#pragma unroll
                for (int bj = 0; bj < 2; ++bj) { const int c = bj * 128 + wc * 32 + 8 * fq, i = c >> 4, cc = c & 15;
                    const f32x4 v0 = acc[ai][bj][m][0], v1 = acc[ai][bj][m][1];
                    u32x4 w; w.x = pg8::cvt_pk_bf16(gelu_tanh(v0[0]), gelu_tanh(v0[1])); w.y = pg8::cvt_pk_bf16(gelu_tanh(v0[2]), gelu_tanh(v0[3])); w.z = pg8::cvt_pk_bf16(gelu_tanh(v1[0]), gelu_tanh(v1[1])); w.w = pg8::cvt_pk_bf16(gelu_tanh(v1[2]), gelu_tanh(v1[3]));
                    *(u32x4*)(Gb + (size_t)(ch * 16 + i) * SW + g * 16 + cc) = w; } }
    }
};
__device__ __forceinline__ void ps3_ssm_y(Frame& F) {
    SsmSched S{F.G, F.vcu, AK, (const char*)WSP(bf16, WS_ASSM), (const char*)WSP(bf16, WS_BTY)};
    EpiSsmY Ep{(bf16*)((unsigned char*)F.out + DO_G)};
    pg8::gemm_phase<EpiSsmY, SsmSched, true>(F.lds, AK * 2, S, Ep);
}

__device__ __forceinline__ void p5_prefill(Frame& F) {
    LAS float* wT = (LAS float*)F.lds;
    LAS int* hist = (LAS int*)(wT + 32 * 1024 + 8 * 2 * 32);
    for (int k = ((int)tidx()); k < DM; k += 512) {
        const f32x4* src = (const f32x4*)(F.in[I_WROUTER] + (size_t)k * NE);
#pragma unroll
        for (int q = 0; q < 8; ++q) { const f32x4 v = src[q]; wT[(4 * q + 0) * 1024 + k] = v.x; wT[(4 * q + 1) * 1024 + k] = v.y; wT[(4 * q + 2) * 1024 + k] = v.z; wT[(4 * q + 3) * 1024 + k] = v.w; }
    }
    if (((int)tidx()) < 32) hist[((int)tidx())] = 0;
    __syncthreads();
}
__device__ __forceinline__ void p5_ln1_router(Frame& F) {
    LAS float* wT = (LAS float*)F.lds;
    LAS float* lg = wT + 32 * 1024;
    LAS int* hist = (LAS int*)(lg + 8 * 2 * 32);
    LAS int* sbase = hist + 32; LAS int* scur = sbase + 32; LAS int* tel = scur + 32;
    const bf16* Z = WSP(bf16, WS_XN) + (size_t)256 * DM; f32x2* STAT = (f32x2*)(F.ws + WS_STAT); int* tok_e = WSP(int, WS_TOKE); float* tok_g = WSP(float, WS_TOKG);
    const int lane = ((int)(tidx() & 63u));
    for (int pr = 0; pr < 8; ++pr) {
        const int t0 = F.vcu * 128 + F.wave * 16 + pr * 2;
        f32x4 h0[4], h1[4];
        {
            const u32x2* z0 = (const u32x2*)(Z + (size_t)t0 * DM) + lane; const u32x2* z1 = z0 + DM / 4;
            float s0 = 0.f, s1 = 0.f;
#pragma unroll
            for (int j = 0; j < 4; ++j) { const u32x2 a = __builtin_nontemporal_load(z0 + 64 * j), c = __builtin_nontemporal_load(z1 + 64 * j); h0[j] = (f32x4){bflo(a.x), bfhi(a.x), bflo(a.y), bfhi(a.y)}; h1[j] = (f32x4){bflo(c.x), bfhi(c.x), bflo(c.y), bfhi(c.y)};
                s0 += (h0[j].x + h0[j].y) + (h0[j].z + h0[j].w); s1 += (h1[j].x + h1[j].y) + (h1[j].z + h1[j].w); }
            const float m0 = wave_sum(s0) * (1.f / DM), m1 = wave_sum(s1) * (1.f / DM); float q0 = 0.f, q1 = 0.f;
#pragma unroll
            for (int j = 0; j < 4; ++j) { h0[j] = h0[j] - m0; h1[j] = h1[j] - m1; q0 += (h0[j].x * h0[j].x + h0[j].y * h0[j].y) + (h0[j].z * h0[j].z + h0[j].w * h0[j].w);
                q1 += (h1[j].x * h1[j].x + h1[j].y * h1[j].y) + (h1[j].z * h1[j].z + h1[j].w * h1[j].w); }
            const float r0 = rsqrtf(wave_sum(q0) * (1.f / DM) + LN_EPS), r1 = rsqrtf(wave_sum(q1) * (1.f / DM) + LN_EPS);
            if (lane == 0) { STAT[t0] = (f32x2){m0, r0}; STAT[t0 + 1] = (f32x2){m1, r1}; }
            unsigned* q8a = (unsigned*)(F.ws + WS_H1Q + (size_t)t0 * DM) + lane; unsigned* q8b = q8a + DM / 4;
#pragma unroll
            for (int j = 0; j < 4; ++j) { const f32x4 gg = ((const f32x4*)F.in[I_LN1G])[lane + 64 * j], bb = ((const f32x4*)F.in[I_LN1B])[lane + 64 * j];
                h0[j] = h0[j] * r0 * gg + bb; h1[j] = h1[j] * r1 * gg + bb;
                unsigned qa = __builtin_amdgcn_cvt_pk_fp8_f32(h0[j].x, h0[j].y, 0, false); qa = __builtin_amdgcn_cvt_pk_fp8_f32(h0[j].z, h0[j].w, qa, true); q8a[64 * j] = qa;
                unsigned qb = __builtin_amdgcn_cvt_pk_fp8_f32(h1[j].x, h1[j].y, 0, false); qb = __builtin_amdgcn_cvt_pk_fp8_f32(h1[j].z, h1[j].w, qb, true); q8b[64 * j] = qb; }
        }
        float p0[32], p1[32];
        {   f32x2 hp[16];
#pragma unroll
            for (int j = 0; j < 4; ++j) { hp[4 * j] = (f32x2){h0[j].x, h1[j].x}; hp[4 * j + 1] = (f32x2){h0[j].y, h1[j].y}; hp[4 * j + 2] = (f32x2){h0[j].z, h1[j].z}; hp[4 * j + 3] = (f32x2){h0[j].w, h1[j].w}; }
#pragma unroll
            for (int eg = 0; eg < 8; ++eg) {
                f32x4 w[4][4];
#pragma unroll
                for (int q = 0; q < 4; ++q)
#pragma unroll
                    for (int j = 0; j < 4; ++j) w[q][j] = *(const LAS f32x4*)(wT + (4 * eg + q) * 1024 + 256 * j + 4 * lane);
                __builtin_amdgcn_sched_barrier(0);
                f32x2 a[4];
#pragma unroll
                for (int q = 0; q < 4; ++q) a[q] = (f32x2){0.f, 0.f};
#pragma unroll
                for (int j = 0; j < 4; ++j) {
#pragma unroll
                    for (int q = 0; q < 4; ++q) a[q] = hp[4 * j] * (f32x2){w[q][j].x, w[q][j].x} + a[q];
#pragma unroll
                    for (int q = 0; q < 4; ++q) a[q] = hp[4 * j + 1] * (f32x2){w[q][j].y, w[q][j].y} + a[q];
#pragma unroll
                    for (int q = 0; q < 4; ++q) a[q] = hp[4 * j + 2] * (f32x2){w[q][j].z, w[q][j].z} + a[q];
#pragma unroll
                    for (int q = 0; q < 4; ++q) a[q] = hp[4 * j + 3] * (f32x2){w[q][j].w, w[q][j].w} + a[q]; }
#pragma unroll
                for (int q = 0; q < 4; ++q) { p0[4 * eg + q] = a[q].x; p1[4 * eg + q] = a[q].y; }
            }
        }
        reduce_scatter32(p0, lane); reduce_scatter32(p1, lane);
        const float l0 = p0[0] + dpp_f<DPP_XOR1>(p0[0]), l1 = p1[0] + dpp_f<DPP_XOR1>(p1[0]);
        const int e_me = lane >> 1; const float br = F.in[I_BROUTER][e_me];
        float v = ((lane & 1) ? l1 : l0) + br; float tv[4]; int te[4];
#pragma unroll
        for (int k = 0; k < 4; ++k) {
            float bv = v; int be = e_me;
            { float ov = dpp_f<DPP_XOR2>(bv); int oe = dpp_i<DPP_XOR2>(be); bool take = (ov > bv) || (ov == bv && oe < be); bv = take ? ov : bv; be = take ? oe : be;
              ov = dpp_f<DPP_ROR4>(bv); oe = dpp_i<DPP_ROR4>(be); take = (ov > bv) || (ov == bv && oe < be); bv = take ? ov : bv; be = take ? oe : be;
              ov = dpp_f<DPP_ROR8>(bv); oe = dpp_i<DPP_ROR8>(be); take = (ov > bv) || (ov == bv && oe < be); bv = take ? ov : bv; be = take ? oe : be;
              { auto rv = __builtin_amdgcn_permlane16_swap(__float_as_uint(bv), __float_as_uint(bv), false, false); auto re = __builtin_amdgcn_permlane16_swap((unsigned)be, (unsigned)be, false, false);
                const float v0 = __uint_as_float(rv[0]), v1 = __uint_as_float(rv[1]); const int e0 = (int)re[0], e1 = (int)re[1]; take = (v1 > v0) || (v1 == v0 && e1 < e0); bv = take ? v1 : v0; be = take ? e1 : e0; }
              { auto rv = __builtin_amdgcn_permlane32_swap(__float_as_uint(bv), __float_as_uint(bv), false, false); auto re = __builtin_amdgcn_permlane32_swap((unsigned)be, (unsigned)be, false, false);
                const float v0 = __uint_as_float(rv[0]), v1 = __uint_as_float(rv[1]); const int e0 = (int)re[0], e1 = (int)re[1]; take = (v1 > v0) || (v1 == v0 && e1 < e0); bv = take ? v1 : v0; be = take ? e1 : e0; } }
            tv[k] = bv; te[k] = be; if (e_me == be) v = -3.0e38f;
        }
        if (lane < 2) {
            const int t = t0 + lane;
            const float e1 = __expf(tv[1] - tv[0]), e2 = __expf(tv[2] - tv[0]), e3 = __expf(tv[3] - tv[0]); const float inv = 1.0f / (1.0f + e1 + e2 + e3);
            *(int4*)(tok_e + t * 4) = make_int4(te[0], te[1], te[2], te[3]);
            { LAS int* tl = tel + (t - F.vcu * 128) * 4; tl[0] = te[0]; tl[1] = te[1]; tl[2] = te[2]; tl[3] = te[3]; }
            *(f32x4*)(tok_g + t * 4) = (f32x4){inv, e1 * inv, e2 * inv, e3 * inv};
#pragma unroll
            for (int k = 0; k < 4; ++k) atomicAdd((int*)(hist + te[k]), 1);
        }
    }
    __syncthreads();
    if (((int)tidx()) < 32) { sbase[((int)tidx())] = (int)atomicAdd((unsigned*)(F.ws + WS_CTL) + CW_GTOT + GTOT_STRIDE * ((int)tidx()), (unsigned)hist[((int)tidx())]); scur[((int)tidx())] = 0; }
    __syncthreads();
    {   const int pl = (int)tidx(), pair = F.vcu * 512 + pl;
        const int e = tel[pl];
        const int pos = sbase[e] + atomicAdd((int*)(scur + e), 1);
        WSP(int, WS_RT2)[(size_t)e * MT + pos] = pair >> 2; WSP(int, WS_SD2)[(size_t)e * MT + pos] = pair; }
}

__device__ __forceinline__ void p6_dispatch(Frame&) { }

__device__ __forceinline__ void p9_final(Frame& F, const WaitMid mid) {
    const bf16* H1 = WSP(bf16, WS_XN) + (size_t)256 * DM; const f32x2* STAT = (const f32x2*)(F.ws + WS_STAT); const int lane = ((int)(tidx() & 63u));
    f32x4 g1a[4], b1a[4];
#pragma unroll
    for (int j = 0; j < 4; ++j) { g1a[j] = ((const f32x4*)F.in[I_LN1G])[lane + 64 * j] * ALPHA; b1a[j] = ((const f32x4*)F.in[I_LN1B])[lane + 64 * j] * ALPHA; }
    const int gw = F.vcu * 8 + F.wave, NGW = F.G * 8;
    u32x2 nh[4]; unsigned nq[4][4]; f32x4 ng; f32x2 nst;
#define P9_FETCH(tt) do { const u32x2* hp_ = (const u32x2*)(H1 + (size_t)(tt) * DM) + lane; const unsigned* yp_ = (const unsigned*)((const unsigned char*)F.out + (size_t)(tt) * 4 * DM) + lane; \
        ng = *(const f32x4*)(WSP(float, WS_TOKG) + (size_t)(tt) * 4); nst = STAT[(tt)]; \
        _Pragma("unroll") for (int j = 0; j < 4; ++j) { nh[j] = __builtin_nontemporal_load(hp_ + 64 * j); \
            _Pragma("unroll") for (int k = 0; k < 4; ++k) nq[j][k] = __builtin_nontemporal_load(yp_ + 256 * k + 64 * j); } } while (0)
    if (gw < MT) { const u32x2* hp_ = (const u32x2*)(H1 + (size_t)gw * DM) + lane; ng = *(const f32x4*)(WSP(float, WS_TOKG) + (size_t)gw * 4); nst = STAT[gw];
#pragma unroll
        for (int j = 0; j < 4; ++j) nh[j] = __builtin_nontemporal_load(hp_ + 64 * j); }
    mid();
    if (gw < MT) { const unsigned* yp_ = (const unsigned*)((const unsigned char*)F.out + (size_t)gw * 4 * DM) + lane;
#pragma unroll
        for (int j = 0; j < 4; ++j)
#pragma unroll
            for (int k = 0; k < 4; ++k) nq[j][k] = __builtin_nontemporal_load(yp_ + 256 * k + 64 * j); }
    for (int t = gw; t < MT; t += NGW) {
        const f32x4 gt = ng * (1.0f / YSCALE); const float zm = nst.x, zr = nst.y;
        u32x2 hc[4]; unsigned qc[4][4];
#pragma unroll
        for (int j = 0; j < 4; ++j) { hc[j] = nh[j];
#pragma unroll
            for (int k = 0; k < 4; ++k) qc[j][k] = nq[j][k]; }
        if (t + NGW < MT) P9_FETCH(t + NGW);
        f32x4 v[4]; float s = 0.f;
#pragma unroll
        for (int j = 0; j < 4; ++j) { const u32x2 h = hc[j];
            const unsigned q0 = qc[j][0], q1 = qc[j][1], q2 = qc[j][2], q3 = qc[j][3];
            const f32x2 a0 = __builtin_amdgcn_cvt_pk_f32_fp8(q0, false), a1 = __builtin_amdgcn_cvt_pk_f32_fp8(q0, true), b0 = __builtin_amdgcn_cvt_pk_f32_fp8(q1, false), b1 = __builtin_amdgcn_cvt_pk_f32_fp8(q1, true);
            const f32x2 c0 = __builtin_amdgcn_cvt_pk_f32_fp8(q2, false), c1 = __builtin_amdgcn_cvt_pk_f32_fp8(q2, true), d0 = __builtin_amdgcn_cvt_pk_f32_fp8(q3, false), d1 = __builtin_amdgcn_cvt_pk_f32_fp8(q3, true);
            const f32x4 hz = ((f32x4){bflo(h.x), bfhi(h.x), bflo(h.y), bfhi(h.y)} - zm) * zr * g1a[j] + b1a[j];
            v[j].x = hz.x + ((gt.x * a0.x + gt.y * b0.x) + (gt.z * c0.x + gt.w * d0.x)); v[j].y = hz.y + ((gt.x * a0.y + gt.y * b0.y) + (gt.z * c0.y + gt.w * d0.y));
            v[j].z = hz.z + ((gt.x * a1.x + gt.y * b1.x) + (gt.z * c1.x + gt.w * d1.x)); v[j].w = hz.w + ((gt.x * a1.y + gt.y * b1.y) + (gt.z * c1.y + gt.w * d1.y));
            s += (v[j].x + v[j].y) + (v[j].z + v[j].w); }
        const float mean = wave_sum(s) * (1.f / DM); float s2 = 0.f;
#pragma unroll
        for (int j = 0; j < 4; ++j) { v[j] = v[j] - mean; s2 += (v[j].x * v[j].x + v[j].y * v[j].y) + (v[j].z * v[j].z + v[j].w * v[j].w); }
        const float rstd = rsqrtf(wave_sum(s2) * (1.f / DM) + LN_EPS);
        f32x4* op = (f32x4*)(F.out + (size_t)t * DM) + lane;
#pragma unroll
        for (int j = 0; j < 4; ++j) { const f32x4 gg = ((const f32x4*)F.in[I_LN2G])[lane + 64 * j], bb = ((const f32x4*)F.in[I_LN2B])[lane + 64 * j]; __builtin_nontemporal_store(v[j] * rstd * gg + bb, op + 64 * j); }
    }
#undef P9_FETCH
}

constexpr int NPHASE = 13;
#ifndef MK_N_LAUNCHES
#define MK_N_LAUNCHES 1
#endif
#ifndef PROBE_DOUBLE
#define PROBE_DOUBLE -1
#endif
__global__ void __launch_bounds__(512, 2) hymba_fwd(Args args) {
    extern __shared__ __attribute__((aligned(16))) unsigned char lds_raw[];
    Frame F;
    F.lds = (LAS unsigned char*)lds_raw; F.in = args.in; F.out = args.out; F.ws = args.ws;
    F.wave = __builtin_amdgcn_readfirstlane(tidx() >> 6);
    F.G = gridDim.x; { const int bx = blockIdx.x; F.vcu = (F.G % 8 == 0) ? (bx % 8) * (F.G / 8) + bx / 8 : bx; }
    volatile LAS unsigned* MISC = (volatile LAS unsigned*)(F.lds + MISC_OFF);
    if (((int)tidx()) < 64) MISC[((int)tidx())] = 0u;
    __syncthreads();
    XcdBarrier bar = xcd_barrier_post((unsigned*)(F.ws + WS_CTL) + CW_BAR, MISC + 8);
#if MK_N_LAUNCHES == 1
#define IN(k) true
#else
    const int lo = args.ph_lo, hi = args.ph_hi;
#define IN(k) (lo <= (k) && (k) < hi)
#endif
#define SEAM(k) do { if (IN(k) && IN((k) + 1)) xcd_barrier(bar); } while (0)
    if (IN(0)) { const int reps_ = (PROBE_DOUBLE == 0) ? (args.ph_hi - NPHASE + 2) : 1; for (int r_ = 0; r_ < reps_; ++r_) { p0_prologue(F); } }
    if (IN(0) && IN(1)) xcd_arrive(bar);
    if (IN(0)) p0_weights(F, 1024, 1024 + 128 + 512);
    if (IN(0) && IN(1)) xcd_wait(bar);
    if (IN(1)) { const int reps_ = (PROBE_DOUBLE == 1) ? (args.ph_hi - NPHASE + 2) : 1; for (int r_ = 0; r_ < reps_; ++r_) { p1_inproj(F); } }
    if (IN(1) && IN(2)) xcd_arrive(bar);
    if (IN(2)) ps1_ssm_e(F, WaitMid{&bar, IN(1) && IN(2)});
    if (IN(2) && IN(3)) xcd_arrive(bar);
    if (IN(6)) p6_attention_unit(F, 0);
    if (IN(2) && IN(3)) xcd_wait(bar);
    if (IN(3)) ps2_ssm_carry(F);
    if (IN(3) && IN(4)) xcd_arrive(bar);
    if (IN(6)) p6_attention_unit(F, 1);
    if (IN(3) && IN(4)) xcd_wait(bar);
    if (IN(4)) ps3_ssm_y(F);
    if (IN(4) && IN(5)) xcd_arrive(bar);
    if (IN(6)) p6_attention_unit(F, 2);
    if (IN(4) && IN(5)) xcd_wait(bar);
    if (IN(5)) p3_glu(F);
    if (IN(6)) p6_attention_unit(F, 3);
    if (IN(6) && IN(7)) xcd_arrive(bar);
    if (IN(7)) p4_outproj(F, WaitMid{&bar, IN(6) && IN(7)});
    if (IN(7) && IN(8)) xcd_arrive(bar);
    if (IN(8)) p5_prefill(F);
    if (IN(7) && IN(8)) xcd_wait(bar);
    if (IN(8)) p5_ln1_router(F);
    if (IN(9)) { const int reps_ = (PROBE_DOUBLE == 9) ? (args.ph_hi - NPHASE + 2) : 1; for (int r_ = 0; r_ < reps_; ++r_) { p6_dispatch(F); } }
    SEAM(9);
    if (IN(10)) { const int reps_ = (PROBE_DOUBLE == 10) ? (args.ph_hi - NPHASE + 2) : 1; for (int r_ = 0; r_ < reps_; ++r_) { p7_moe_up(F); } }
    if (IN(10) && IN(11)) xcd_arrive(bar);
    if (IN(11)) moe_tables(F, 4);
    if (IN(11)) p8_moe_down(F, WaitMid{&bar, IN(10) && IN(11)});
    if (IN(11) && IN(12)) xcd_arrive(bar);
    if (IN(12)) p9_final(F, WaitMid{&bar, IN(11) && IN(12)});
#undef IN
#undef SEAM
}

extern "C" void kernel_launch(void* const* d_in, const int* in_sizes, int n_in, void* d_out, int out_size, void* d_ws, size_t ws_size, hipStream_t stream) {
    static int grid = 0;
    if (grid == 0) {
        if (n_in != NIN || in_sizes[0] != MT * DM || out_size != MT * DM || ws_size < WS_END) {
            fprintf(stderr, "kernel_launch: unexpected problem (n_in %d, in0 %d, out %d, ws %zu < %zu); nothing launched\n", n_in, n_in > 0 ? in_sizes[0] : -1, out_size, ws_size, (size_t)WS_END); grid = -1; return; }
        int dev = 0, cus = 0;
        if (hipGetDevice(&dev) != hipSuccess || hipDeviceGetAttribute(&cus, hipDeviceAttributeMultiprocessorCount, dev) != hipSuccess) { grid = -1; return; }
        if (hipFuncSetAttribute((const void*)hymba_fwd, hipFuncAttributeMaxDynamicSharedMemorySize, LDS_BYTES) != hipSuccess) { fprintf(stderr, "kernel_launch: hipFuncSetAttribute failed\n"); grid = -1; return; }
        int per_cu = 0;
        if (hipOccupancyMaxActiveBlocksPerMultiprocessor(&per_cu, (const void*)hymba_fwd, 512, LDS_BYTES) != hipSuccess || per_cu < 1) { fprintf(stderr, "kernel_launch: occupancy query says %d\n", per_cu); }
        (void)hipGetLastError();
        grid = cus;
        if (grid != 256) { fprintf(stderr, "kernel_launch: built for 256 CUs, found %d; nothing launched\n", cus); grid = -1; return; }
    }
    if (grid < 0) return;
    if (hipMemsetAsync((char*)d_ws + WS_CTL, 0, CTL_ZERO_BYTES, stream) != hipSuccess) return;
    Args a{};
    for (int i = 0; i < NIN; ++i) a.in[i] = (const float*)d_in[i];
    a.out = (float*)d_out; a.ws = (unsigned char*)d_ws;
    if (MK_N_LAUNCHES == 1) { a.ph_lo = 0; a.ph_hi = NPHASE; hipLaunchKernelGGL(hymba_fwd, dim3(grid), dim3(512), LDS_BYTES, stream, a); }
    else for (int p = 0; p < NPHASE; ++p) { a.ph_lo = p; a.ph_hi = p + 1; hipLaunchKernelGGL(hymba_fwd, dim3(grid), dim3(512), LDS_BYTES, stream, a); }
}
```
